# Optimizing an MI355X kernel written in HIP

```python
import math
import jax, jax.numpy as jnp
from jax import lax
import numpy as np

D_MODEL = 1024
BATCH = 8
SEQ = 4096
DEPTH = 1
DEC_BATCH = 128
DEC_SEQ = 8
PAST_LEN = 16384
PAGE_SIZE = 128

MIX_DIM = D_MODEL
SSD_D_INNER = MIX_DIM // 2
SSD_HEAD_DIM = 64
SSD_HEADS = SSD_D_INNER // SSD_HEAD_DIM
SSD_GROUPS = 2
SSD_HEADS_PER_GROUP = SSD_HEADS // SSD_GROUPS
D_STATE = 128
CONV_K = 4
CONV_DIM = SSD_D_INNER + 2 * SSD_GROUPS * D_STATE
CHUNK = 128
ATTN_DIM = MIX_DIM - SSD_D_INNER
ATTN_HEAD_DIM = 64
N_HEADS = ATTN_DIM // ATTN_HEAD_DIM
N_KV_HEADS = 2
Q_PER_KV = N_HEADS // N_KV_HEADS
KV_DIM = N_KV_HEADS * ATTN_HEAD_DIM
WINDOW = 128
N_BUCKETS = 32
MAX_EXACT = N_BUCKETS // 2
MAX_DISTANCE = 128
N_MEM = 256
CA_HEADS = 4
CA_HEAD_DIM = 128
CA_DIM = CA_HEADS * CA_HEAD_DIM
D_FF = -(-8 * D_MODEL // (3 * 256)) * 256
IN_DIM = SSD_D_INNER + CONV_DIM + SSD_HEADS + ATTN_DIM + 2 * KV_DIM
SPLITS = (SSD_D_INNER, SSD_D_INNER + CONV_DIM, SSD_D_INNER + CONV_DIM + SSD_HEADS,
          SSD_D_INNER + CONV_DIM + SSD_HEADS + ATTN_DIM,
          SSD_D_INNER + CONV_DIM + SSD_HEADS + ATTN_DIM + KV_DIM)
EPS = 1e-6

kernel_name = 'hymba_ssd_swa_sink_t5_xattn_step'


def rmsnorm(x, g):
    xf = x.astype(jnp.float32)
    y = xf * lax.rsqrt(jnp.mean(xf * xf, axis=-1, keepdims=True) + EPS)
    return (y * g.astype(jnp.float32)).astype(x.dtype)


def gated_group_rmsnorm(y, z, g):
    yf = y.astype(jnp.float32) * jax.nn.silu(z.astype(jnp.float32))
    yg = yf.reshape(yf.shape[:-1] + (SSD_GROUPS, SSD_D_INNER // SSD_GROUPS))
    yg = yg * lax.rsqrt(jnp.mean(yg * yg, axis=-1, keepdims=True) + EPS)
    return (yg.reshape(yf.shape) * g.astype(jnp.float32)).astype(z.dtype)


def ssd_scan(x, dt, A, B, C, h0):
    b, L = x.shape[:2]
    Q = CHUNK if L % CHUNK == 0 else L
    nc = L // Q
    G, Hg, P, N = SSD_GROUPS, SSD_HEADS_PER_GROUP, SSD_HEAD_DIM, D_STATE
    x = x.reshape(b, nc, Q, G, Hg, P)
    dt = dt.reshape(b, nc, Q, G, Hg)
    B = B.reshape(b, nc, Q, G, N)
    C = C.reshape(b, nc, Q, G, N)
    cs = jnp.cumsum(dt * A.reshape(G, Hg), axis=2)
    xdt = x * dt[..., None]
    causal = jnp.tril(jnp.ones((Q, Q), dtype=bool))[:, :, None, None]
    diff = cs[:, :, :, None] - cs[:, :, None, :]
    decay_qs = jnp.exp(jnp.where(causal, diff, -jnp.inf))
    cb = jnp.einsum('bcqgn,bcsgn->bcqsg', C, B)
    y_diag = jnp.einsum('bcqsgh,bcsghp->bcqghp', cb[..., None] * decay_qs, xdt)
    decay_end = jnp.exp(cs[:, :, -1:] - cs)
    st = jnp.einsum('bcsgn,bcsghp->bcghpn', B, xdt * decay_end[..., None])
    chunk_decay = jnp.exp(cs[:, :, -1])

    def step(h, inp):
        dec, s = inp
        return dec[..., None, None] * h + s, h

    h_final, h_starts = lax.scan(step, h0.reshape(b, G, Hg, P, N),
                                 (jnp.moveaxis(chunk_decay, 1, 0), jnp.moveaxis(st, 1, 0)))
    h_starts = jnp.moveaxis(h_starts, 0, 1)
    y_off = jnp.einsum('bcqgn,bcghpn->bcqghp', C, h_starts) * jnp.exp(cs)[..., None]
    y = (y_diag + y_off).reshape(b, L, SSD_HEADS, P)
    return y, h_final.reshape(b, SSD_HEADS, P, N)


def ssd_branch(z, xbc, dt_raw, conv_prev, ssm_prev, conv_w, conv_b, dt_bias, a_log, d_skip, g_norm):
    b, L, _ = xbc.shape
    xp = jnp.concatenate([conv_prev.astype(xbc.dtype), xbc], axis=1)
    conv = conv_b.astype(jnp.float32)
    for k in range(CONV_K):
        conv = conv + xp[:, k:k + L].astype(jnp.float32) * conv_w[k].astype(jnp.float32)
    conv = jax.nn.silu(conv)
    new_conv = xp[:, L:].astype(conv_prev.dtype)
    xs, Bm, Cm = jnp.split(conv, [SSD_D_INNER, SSD_D_INNER + SSD_GROUPS * D_STATE], axis=-1)
    xs = xs.reshape(b, L, SSD_HEADS, SSD_HEAD_DIM)
    Bm = Bm.reshape(b, L, SSD_GROUPS, D_STATE)
    Cm = Cm.reshape(b, L, SSD_GROUPS, D_STATE)
    dt = jax.nn.softplus(dt_raw.astype(jnp.float32) + dt_bias.astype(jnp.float32))
    A = -jnp.exp(a_log.astype(jnp.float32))
    y, new_ssm = ssd_scan(xs, dt, A, Bm, Cm, ssm_prev.astype(jnp.float32))
    y = y + d_skip.astype(jnp.float32)[:, None] * xs
    y = gated_group_rmsnorm(y.reshape(b, L, SSD_D_INNER), z, g_norm)
    return y, new_conv, new_ssm.astype(ssm_prev.dtype)


def t5_bucket(dist):
    n = jnp.maximum(dist, 0)
    large = MAX_EXACT + (jnp.log(jnp.maximum(n, 1).astype(jnp.float32) / MAX_EXACT)
                         / math.log(MAX_DISTANCE / MAX_EXACT) * (N_BUCKETS - MAX_EXACT)).astype(jnp.int32)
    large = jnp.minimum(large, N_BUCKETS - 1)
    return jnp.where(n < MAX_EXACT, n, large)


def rel_bias_logits(rel_bias, dist):
    bias = rel_bias.astype(jnp.float32)[t5_bucket(dist)]
    q_len, s_len = dist.shape
    return jnp.transpose(bias, (2, 0, 1)).reshape(N_KV_HEADS, Q_PER_KV, q_len, s_len)


def sink_attention(q, k, v, bias, mask, sinks):
    s = jnp.einsum('...qkgd,...skd->...kgqs', q, k).astype(jnp.float32) * (ATTN_HEAD_DIM ** -0.5) + bias
    s = jnp.where(mask, s, -jnp.inf)
    sk = sinks.astype(jnp.float32)[:, :, None, None]
    m = jnp.maximum(jnp.max(s, axis=-1, keepdims=True), sk)
    p = jnp.exp(s - m)
    p = p / (jnp.sum(p, axis=-1, keepdims=True) + jnp.exp(sk - m))
    return jnp.einsum('...kgqs,...skd->...qkgd', p.astype(v.dtype), v)


def swa_banded(q, k, v, sinks, rel_bias):
    b, L = q.shape[:2]
    nb = L // WINDOW
    qb = q.reshape(b, nb, WINDOW, N_KV_HEADS, Q_PER_KV, ATTN_HEAD_DIM)

    def band(t):
        tp = jnp.concatenate([jnp.zeros((b, WINDOW) + t.shape[2:], t.dtype), t], axis=1)
        tp = tp.reshape(b, nb + 1, WINDOW, N_KV_HEADS, ATTN_HEAD_DIM)
        return jnp.concatenate([tp[:, :-1], tp[:, 1:]], axis=2)

    kb, vb = band(k), band(v)
    j = jnp.arange(2 * WINDOW)
    dist = jnp.arange(WINDOW)[:, None] + WINDOW - j[None, :]
    inband = (dist >= 0) & (dist < WINDOW)
    key_pos = jnp.arange(nb)[:, None] * WINDOW - WINDOW + j[None, :]
    mask = inband[None] & (key_pos >= 0)[:, None, :]
    out = sink_attention(qb, kb, vb, rel_bias_logits(rel_bias, dist), mask[:, None, None], sinks)
    return out.reshape(b, L, ATTN_DIM)


def swa_with_buffer(q, k, v, k_buf, v_buf, sinks, rel_bias):
    b, T = q.shape[:2]
    lb = k_buf.shape[1]
    kk = jnp.concatenate([k_buf.astype(k.dtype), k], axis=1)
    vv = jnp.concatenate([v_buf.astype(v.dtype), v], axis=1)
    dist = jnp.arange(T)[:, None] + lb - jnp.arange(lb + T)[None, :]
    mask = (dist >= 0) & (dist < WINDOW)
    out = sink_attention(q, kk, vv, rel_bias_logits(rel_bias, dist), mask, sinks)
    return out.reshape(b, T, ATTN_DIM), kk[:, T:].astype(k_buf.dtype), vv[:, T:].astype(v_buf.dtype)


def memory_kv(mem, g_mem, w_ck, w_cv):
    b, m, _ = mem.shape
    mn = rmsnorm(mem, g_mem)
    return ((mn @ w_ck).reshape(b, m, CA_HEADS, CA_HEAD_DIM),
            (mn @ w_cv).reshape(b, m, CA_HEADS, CA_HEAD_DIM))


def cross_attention(hn, mem_k, mem_v, w_cq, w_co):
    b, L, _ = hn.shape
    q = (hn @ w_cq).reshape(b, L, CA_HEADS, CA_HEAD_DIM)
    s = jnp.einsum('blhd,bmhd->bhlm', q, mem_k.astype(q.dtype)).astype(jnp.float32) * (CA_HEAD_DIM ** -0.5)
    p = jax.nn.softmax(s, axis=-1).astype(q.dtype)
    o = jnp.einsum('bhlm,bmhd->blhd', p, mem_v.astype(q.dtype))
    return o.reshape(b, L, CA_DIM) @ w_co


def decoder_layer(h, mem_k, mem_v, conv_prev, ssm_prev, k_buf, v_buf, rel_bias,
                  g_mix, w_in, conv_w, conv_b, dt_bias, a_log, d_skip, g_ssd_norm, sinks, w_out,
                  g_cross, w_cq, w_co, g_ffn, w_gate, w_up, w_down):
    b, L, _ = h.shape
    xn = rmsnorm(h, g_mix)
    z, xbc, dt_raw, q, k, v = jnp.split(xn @ w_in, SPLITS, axis=-1)
    y_ssd, new_conv, new_ssm = ssd_branch(z, xbc, dt_raw, conv_prev, ssm_prev, conv_w, conv_b,
                                          dt_bias, a_log, d_skip, g_ssd_norm)
    q = q.reshape(b, L, N_KV_HEADS, Q_PER_KV, ATTN_HEAD_DIM)
    k = k.reshape(b, L, N_KV_HEADS, ATTN_HEAD_DIM)
    v = v.reshape(b, L, N_KV_HEADS, ATTN_HEAD_DIM)
    sk = sinks.reshape(N_KV_HEADS, Q_PER_KV)
    if k_buf is None:
        y_att = swa_banded(q, k, v, sk, rel_bias)
        keep = min(WINDOW, L)
        new_k, new_v = k[:, L - keep:], v[:, L - keep:]
    else:
        y_att, new_k, new_v = swa_with_buffer(q, k, v, k_buf, v_buf, sk, rel_bias)
    mix = jnp.concatenate([y_ssd.astype(h.dtype), y_att.astype(h.dtype)], axis=-1)
    h = h + mix @ w_out
    h = h + cross_attention(rmsnorm(h, g_cross), mem_k, mem_v, w_cq, w_co)
    hn = rmsnorm(h, g_ffn)
    h = h + (jax.nn.silu(hn @ w_gate) * (hn @ w_up)) @ w_down
    return h, new_conv, new_ssm, new_k, new_v


def setup_inputs(seed: int = 0) -> dict:
    key = jax.random.key(seed)
    ks = iter(jax.random.split(key, 40))
    f32 = jnp.float32

    def nrm(shape, scale):
        return jax.random.normal(next(ks), shape, f32) * scale

    def gain(shape):
        return 1.0 + nrm(shape, 0.02)

    swa_buf = min(WINDOW, PAST_LEN)
    u = jax.random.uniform(next(ks), (DEPTH, SSD_HEADS), f32)
    dt0 = jnp.exp(u * (math.log(0.1) - math.log(0.001)) + math.log(0.001))
    dt_bias = dt0 + jnp.log(-jnp.expm1(-dt0))
    a_log = jnp.log(jax.random.uniform(next(ks), (DEPTH, SSD_HEADS), f32, minval=1.0, maxval=16.0))
    return {
        'x_prompt': nrm((BATCH, SEQ, D_MODEL), 1.0),
        'x_sample': nrm((DEC_BATCH, DEC_SEQ, D_MODEL), 1.0),
        'mem_prompt': nrm((BATCH, N_MEM, D_MODEL), 1.0),
        'state_conv': nrm((DEPTH, DEC_BATCH, CONV_K - 1, CONV_DIM), 1.0),
        'state_ssm': nrm((DEPTH, DEC_BATCH, SSD_HEADS, SSD_HEAD_DIM, D_STATE), 0.1),
        'cache_swa_k': nrm((DEPTH, DEC_BATCH, swa_buf, N_KV_HEADS, ATTN_HEAD_DIM), 1.0),
        'cache_swa_v': nrm((DEPTH, DEC_BATCH, swa_buf, N_KV_HEADS, ATTN_HEAD_DIM), 1.0),
        'cache_mem_k': nrm((DEPTH, DEC_BATCH, N_MEM, CA_HEADS, CA_HEAD_DIM), 1.0),
        'cache_mem_v': nrm((DEPTH, DEC_BATCH, N_MEM, CA_HEADS, CA_HEAD_DIM), 1.0),
        'rel_bias': nrm((N_BUCKETS, N_HEADS), 0.5),
        'g_mix': gain((DEPTH, D_MODEL)),
        'w_in': nrm((DEPTH, D_MODEL, IN_DIM), D_MODEL ** -0.5),
        'conv_w': nrm((DEPTH, CONV_K, CONV_DIM), CONV_K ** -0.5),
        'conv_b': nrm((DEPTH, CONV_DIM), 0.02),
        'dt_bias': dt_bias,
        'a_log': a_log,
        'd_skip': 1.0 + nrm((DEPTH, SSD_HEADS), 0.1),
        'g_ssd_norm': gain((DEPTH, SSD_D_INNER)),
        'sinks': nrm((DEPTH, N_HEADS), 0.5),
        'w_out': nrm((DEPTH, MIX_DIM, D_MODEL), MIX_DIM ** -0.5),
        'g_cross': gain((DEPTH, D_MODEL)),
        'g_mem': gain((DEPTH, D_MODEL)),
        'w_cq': nrm((DEPTH, D_MODEL, CA_DIM), D_MODEL ** -0.5),
        'w_ck': nrm((DEPTH, D_MODEL, CA_DIM), D_MODEL ** -0.5),
        'w_cv': nrm((DEPTH, D_MODEL, CA_DIM), D_MODEL ** -0.5),
        'w_co': nrm((DEPTH, CA_DIM, D_MODEL), CA_DIM ** -0.5),
        'g_ffn': gain((DEPTH, D_MODEL)),
        'w_gate': nrm((DEPTH, D_MODEL, D_FF), D_MODEL ** -0.5),
        'w_up': nrm((DEPTH, D_MODEL, D_FF), D_MODEL ** -0.5),
        'w_down': nrm((DEPTH, D_FF, D_MODEL), D_FF ** -0.5),
        'g_final': gain((D_MODEL,)),
    }


def reference(x_prompt, x_sample, mem_prompt, state_conv, state_ssm, cache_swa_k, cache_swa_v,
              cache_mem_k, cache_mem_v, rel_bias, g_mix, w_in, conv_w, conv_b, dt_bias, a_log,
              d_skip, g_ssd_norm, sinks, w_out, g_cross, g_mem, w_cq, w_ck, w_cv, w_co, g_ffn,
              w_gate, w_up, w_down, g_final):
    bp = x_prompt.shape[0]
    hp, hs = x_prompt, x_sample
    p_conv, p_ssm, p_k, p_v, p_mk, p_mv = [], [], [], [], [], []
    s_conv, s_ssm, s_k, s_v = [], [], [], []
    for l in range(DEPTH):
        lw = (g_mix[l], w_in[l], conv_w[l], conv_b[l], dt_bias[l], a_log[l], d_skip[l], g_ssd_norm[l],
              sinks[l], w_out[l], g_cross[l], w_cq[l], w_co[l], g_ffn[l], w_gate[l], w_up[l], w_down[l])
        mk, mv = memory_kv(mem_prompt, g_mem[l], w_ck[l], w_cv[l])
        conv0 = jnp.zeros((bp, CONV_K - 1, CONV_DIM), x_prompt.dtype)
        ssm0 = jnp.zeros((bp, SSD_HEADS, SSD_HEAD_DIM, D_STATE), jnp.float32)
        hp, c_new, h_new, k_new, v_new = decoder_layer(hp, mk, mv, conv0, ssm0, None, None, rel_bias, *lw)
        p_conv.append(c_new); p_ssm.append(h_new); p_k.append(k_new); p_v.append(v_new)
        p_mk.append(mk); p_mv.append(mv)
        hs, c_new, h_new, k_new, v_new = decoder_layer(hs, cache_mem_k[l], cache_mem_v[l], state_conv[l],
                                                       state_ssm[l], cache_swa_k[l], cache_swa_v[l],
                                                       rel_bias, *lw)
        s_conv.append(c_new); s_ssm.append(h_new); s_k.append(k_new); s_v.append(v_new)
    y_prompt = rmsnorm(hp, g_final)
    y_sample = rmsnorm(hs, g_final)
    return (y_prompt, y_sample,
            jnp.stack(p_conv), jnp.stack(p_ssm), jnp.stack(p_k), jnp.stack(p_v),
            jnp.stack(p_mk), jnp.stack(p_mv),
            jnp.stack(s_conv), jnp.stack(s_ssm), jnp.stack(s_k), jnp.stack(s_v))
```

```cpp
#include <hip/hip_runtime.h>
#include <cstdio>
#include <cstdint>
#include <cmath>
namespace pg8 {
#define PG8_LAS __attribute__((address_space(3)))
typedef unsigned short bf16_t;
typedef short bf16x8 __attribute__((ext_vector_type(8)));
typedef float f32x4 __attribute__((ext_vector_type(4)));
typedef unsigned u32x4 __attribute__((ext_vector_type(4)));
constexpr int BM = 256, BK = 64, HALF = 128, HTB = HALF * BK * 2  , STAGE_BYTES = 8 * HTB, NXCD = 8, WGM = 8;

__host__ __device__ __forceinline__ int lds_byte(int r, int c) { const int st = (r >> 4) * 2 + (c >> 5), rr = r & 15, cc = c & 31, ob = rr * 64 + cc * 2; return st * 1024 + (ob ^ (((ob >> 9) & 1) << 5)); }
__host__ __device__ __forceinline__ void stage_rc(int b, int& R, int& C) { const int st = b / 1024, sb = b % 1024, swz = sb ^ (((sb >> 9) & 1) << 5); R = (st >> 1) * 16 + swz / 64; C = (st & 1) * 32 + (swz % 64) / 2; }
__host__ __device__ __forceinline__ int perm32(int rho) { const int n = rho >> 4, i = rho & 15; return 8 * (i >> 2) + 4 * n + (i & 3); }

struct Unit { int pm, pn; };
struct Gemm { const bf16_t* A; const bf16_t* Bt; int M, N, K; };

struct StaticOrder {
    int nM, nN, nwg, G, c;
    __host__ __device__ void init(int M, int N, int G_, int c_) { nM = M / BM; nN = N / BM; nwg = nM * nN; G = G_; c = c_; }
    __host__ __device__ bool next(int i, Unit& u) const {
        const long L = (long)i * G + c; if (L >= nwg) return false;
        int wgid = (int)L; { const int q = nwg / NXCD, r = nwg % NXCD, xcd = wgid % NXCD, off = wgid / NXCD; wgid = (xcd < r ? xcd * (q + 1) : r * (q + 1) + (xcd - r) * q) + off; }
        const int nig = WGM * nN, gid = wgid / nig, fm = gid * WGM, gsz = (nM - fm) < WGM ? (nM - fm) : WGM;
        u.pm = fm + ((wgid % nig) % gsz); u.pn = (wgid % nig) / gsz; return true;
    }
    __device__ __forceinline__ void a_ready(const Unit&) const {}
    __device__ __forceinline__ void done(const Unit&) const {}
};

__device__ __forceinline__ unsigned cvt_pk_bf16(float lo, float hi) { unsigned r; asm volatile("v_cvt_pk_bf16_f32 %0, %1, %2" : "=v"(r) : "v"(lo), "v"(hi)); return r; }
typedef unsigned u32x2 __attribute__((ext_vector_type(2)));
constexpr float RMS_EPS = 1e-6f;
__device__ __forceinline__ float row_rstd(const float* ssq, int row, int fq) {
    const f32x4 p = *(const f32x4*)(ssq + (size_t)row * 16 + 4 * fq);
    float s = (p[0] + p[1]) + (p[2] + p[3]);
    s += __shfl_xor(s, 16); s += __shfl_xor(s, 32);
    return __builtin_amdgcn_rsqf(s * (1.0f / 1024.0f) + RMS_EPS);
}
__device__ __forceinline__ float silu_f(float x) { return x * __builtin_amdgcn_rcpf(1.0f + __expf(-x)); }

struct EpiBf16P {
    static constexpr bool PERM = true, AFTER_DRAIN = false;
    bf16_t* O; int ldc;
    __device__ __forceinline__ void operator()(const f32x4 (&acc)[2][2][4][2], const Unit& u, int wr, int wc, int fr, int fq) const {
        const int row0 = u.pm * BM + wr * 64 + fr, col0 = u.pn * BM + wc * 32 + 8 * fq;
#pragma unroll
        for (int ai = 0; ai < 2; ++ai)
#pragma unroll
            for (int m = 0; m < 4; ++m) { bf16_t* rowp = O + (size_t)(row0 + ai * HALF + m * 16) * ldc + col0;
#pragma unroll
                for (int bj = 0; bj < 2; ++bj) { const f32x4 v0 = acc[ai][bj][m][0], v1 = acc[ai][bj][m][1];
                    u32x4 w; w.x = cvt_pk_bf16(v0[0], v0[1]); w.y = cvt_pk_bf16(v0[2], v0[3]); w.z = cvt_pk_bf16(v1[0], v1[1]); w.w = cvt_pk_bf16(v1[2], v1[3]);
                    *(u32x4*)(rowp + bj * HALF) = w; } }
    }
};
struct EpiScaleBf16 {
    static constexpr bool PERM = true, AFTER_DRAIN = false;
    bf16_t* O; int ldc; const float* ssq; float scale;
    __device__ __forceinline__ void operator()(const f32x4 (&acc)[2][2][4][2], const Unit& u, int wr, int wc, int fr, int fq) const {
        const int row0 = u.pm * BM + wr * 64 + fr, col0 = u.pn * BM + wc * 32 + 8 * fq;
#pragma unroll
        for (int ai = 0; ai < 2; ++ai)
#pragma unroll
            for (int m = 0; m < 4; ++m) { const int row = row0 + ai * HALF + m * 16; const float r = row_rstd(ssq, row, fq) * scale; bf16_t* rowp = O + (size_t)row * ldc + col0;
#pragma unroll
                for (int bj = 0; bj < 2; ++bj) { const f32x4 v0 = acc[ai][bj][m][0] * r, v1 = acc[ai][bj][m][1] * r;
                    u32x4 w; w.x = cvt_pk_bf16(v0[0], v0[1]); w.y = cvt_pk_bf16(v0[2], v0[3]); w.z = cvt_pk_bf16(v1[0], v1[1]); w.w = cvt_pk_bf16(v1[2], v1[3]);
                    *(u32x4*)(rowp + bj * HALF) = w; } }
    }
};
struct EpiSwiGLU {
    static constexpr bool PERM = true, AFTER_DRAIN = false;
    bf16_t* O; int ldc; const float* ssq;
    __device__ __forceinline__ void operator()(const f32x4 (&acc)[2][2][4][2], const Unit& u, int wr, int wc, int fr, int fq) const {
        const int row0 = u.pm * BM + wr * 64 + fr, col0 = u.pn * HALF + wc * 32 + 8 * fq;
#pragma unroll
        for (int ai = 0; ai < 2; ++ai)
#pragma unroll
            for (int m = 0; m < 4; ++m) { const int row = row0 + ai * HALF + m * 16; const float r = row_rstd(ssq, row, fq);
                float h[8];
#pragma unroll
                for (int n = 0; n < 2; ++n)
#pragma unroll
                    for (int e = 0; e < 4; ++e) { const float g = acc[ai][0][m][n][e] * r, up = acc[ai][1][m][n][e] * r; h[4 * n + e] = silu_f(g) * up; }
                u32x4 w; w.x = cvt_pk_bf16(h[0], h[1]); w.y = cvt_pk_bf16(h[2], h[3]); w.z = cvt_pk_bf16(h[4], h[5]); w.w = cvt_pk_bf16(h[6], h[7]);
                *(u32x4*)(O + (size_t)row * ldc + col0) = w; }
    }
};
struct EpiResid {
    static constexpr bool PERM = false, AFTER_DRAIN = false;
    const float* base0; const float* base1; int split; float* out; bf16_t* ob; float* ssq;
    __device__ __forceinline__ void operator()(const f32x4 (&acc)[2][2][4][2], const Unit& u, int wr, int wc, int fr, int fq) const {
        const int row0 = u.pm * BM + wr * 64 + fr, col0 = u.pn * BM + wc * 32 + 4 * fq;
#pragma unroll
        for (int ai = 0; ai < 2; ++ai)
#pragma unroll
            for (int m = 0; m < 4; ++m) { const int row = row0 + ai * HALF + m * 16;
                const float* bp = (row < split ? base0 + (size_t)row * 1024 : base1 + (size_t)(row - split) * 1024) + col0;
                float* op = out + (size_t)row * 1024 + col0; float ss = 0.f;
#pragma unroll
                for (int bj = 0; bj < 2; ++bj)
#pragma unroll
                    for (int n = 0; n < 2; ++n) { const int c = bj * HALF + n * 16; const f32x4 b = *(const f32x4*)(bp + c); const f32x4 v = b + acc[ai][bj][m][n];
                        *(f32x4*)(op + c) = v; ss += (v[0] * v[0] + v[1] * v[1]) + (v[2] * v[2] + v[3] * v[3]);
                        if (ob) { u32x2 w; w.x = cvt_pk_bf16(v[0], v[1]); w.y = cvt_pk_bf16(v[2], v[3]); *(u32x2*)(ob + (size_t)row * 1024 + col0 + c) = w; } }
                ss += __shfl_xor(ss, 16); ss += __shfl_xor(ss, 32);
                if (fq == 0) ssq[(size_t)row * 16 + u.pn * 4 + wc] = ss; }
    }
};
struct EpiMemKV {
    static constexpr bool PERM = false, AFTER_DRAIN = false;
    float* outk; float* outv; bf16_t* ob;
    __device__ __forceinline__ void operator()(const f32x4 (&acc)[2][2][4][2], const Unit& u, int wr, int wc, int fr, int fq) const {
        const int row0 = u.pm * BM + wr * 64 + fr, col0 = u.pn * BM + wc * 32 + 4 * fq;
#pragma unroll
        for (int ai = 0; ai < 2; ++ai)
#pragma unroll
            for (int m = 0; m < 4; ++m) { const int row = row0 + ai * HALF + m * 16;
#pragma unroll
                for (int bj = 0; bj < 2; ++bj)
#pragma unroll
                    for (int n = 0; n < 2; ++n) { const int c = col0 + bj * HALF + n * 16; const f32x4 v = acc[ai][bj][m][n];
                        float* o = (c < 512) ? outk + (size_t)row * 512 + c : outv + (size_t)row * 512 + (c - 512);
                        *(f32x4*)o = v; u32x2 w; w.x = cvt_pk_bf16(v[0], v[1]); w.y = cvt_pk_bf16(v[2], v[3]); *(u32x2*)(ob + (size_t)row * 1024 + c) = w; } }
    }
};
template <class Epi, class Sched, bool ALIGN_EPI = false, bool SP2 = false>
__device__ __forceinline__ void gemm_phase(PG8_LAS unsigned char* lds, const Gemm g, const Sched& S, const Epi& E) {
    const int tid = threadIdx.x, wid = __builtin_amdgcn_readfirstlane(tid >> 6), lane = tid & 63, wr = wid >> 2, wc = wid & 3, fr = lane & 15, fq = lane >> 4;
    const int K = g.K, nt = K / BK;
    unsigned voffA[2], voffB[2];
#pragma unroll
    for (int i = 0; i < 2; ++i) { int R, C; stage_rc(tid * 16 + i * 8192, R, C); const int Rb = Epi::PERM ? ((R & ~31) + perm32(R & 31)) : R;
        voffA[i] = (unsigned)(R * K + C) * 2u; voffB[i] = (unsigned)(Rb * K + C) * 2u; }
    const size_t kstep = (size_t)(BK * 2);
    const size_t hstep = (size_t)HALF * K * 2;
    const size_t tstep = 2 * hstep;
    const unsigned ldsw = (unsigned)wid * 1024u;
    const int aoff = lds_byte(wr * 64 + fr, fq * 8), boff = lds_byte(wc * 32 + fr, fq * 8);
#define PG8_SA(b, h) (((b) * 2 + (h)) * HTB)
#define PG8_SB(b, h) ((4 + (b) * 2 + (h)) * HTB)
#define PG8_STAGE(bufoff, gbase, voff) do { _Pragma("unroll") for (int _i = 0; _i < 2; ++_i) \
        __builtin_amdgcn_global_load_lds((const unsigned*)((const char*)(gbase) + (voff)[_i]), (PG8_LAS unsigned*)(lds + (bufoff) + ldsw + _i * 8192), 16, 0, 0); } while (0)
#define PG8_LDA(dst, b, h) do { _Pragma("unroll") for (int m = 0; m < 4; ++m) _Pragma("unroll") for (int k = 0; k < 2; ++k) dst[m][k] = *(const PG8_LAS bf16x8*)(lds + PG8_SA(b, h) + aoff + m * 2048 + k * 1024); } while (0)
#define PG8_LDB(dst, b, h) do { _Pragma("unroll") for (int n = 0; n < 2; ++n) _Pragma("unroll") for (int k = 0; k < 2; ++k) dst[n][k] = *(const PG8_LAS bf16x8*)(lds + PG8_SB(b, h) + boff + n * 2048 + k * 1024); } while (0)
#define PG8_MMA(ai, bj, At, Bt) do { __builtin_amdgcn_s_setprio(1); _Pragma("unroll") for (int m = 0; m < 4; ++m) _Pragma("unroll") for (int n = 0; n < 2; ++n) _Pragma("unroll") for (int k = 0; k < 2; ++k) \
        acc[ai][bj][m][n] = __builtin_amdgcn_mfma_f32_16x16x32_bf16(Bt[n][k], At[m][k], acc[ai][bj][m][n], 0, 0, 0); __builtin_amdgcn_s_setprio(0); } while (0)
#define PG8_WAIT_V(n) asm volatile("s_waitcnt vmcnt(" #n ")" ::: "memory")
#define PG8_WAIT_L(n) asm volatile("s_waitcnt lgkmcnt(" #n ")" ::: "memory")
#define PG8_BAR __builtin_amdgcn_s_barrier()
#define PG8_SCHED __builtin_amdgcn_sched_barrier(0)
    Unit cur, nxt; int ui = 0;
    if (!S.next(0, cur)) return;
    f32x4 acc[2][2][4][2];
#pragma unroll
    for (int a = 0; a < 2; ++a)
#pragma unroll
        for (int b = 0; b < 2; ++b)
#pragma unroll
            for (int m = 0; m < 4; ++m)
#pragma unroll
                for (int n = 0; n < 2; ++n) acc[a][b][m][n] = (f32x4){0.f, 0.f, 0.f, 0.f};
    bf16x8 At[4][2], B0[2][2], B1[2][2];
    const char* cA = (const char*)g.A + (size_t)cur.pm * tstep; const char* cB = (const char*)g.Bt + (size_t)cur.pn * tstep;
    S.a_ready(cur);
    if constexpr (SP2) {
        PG8_STAGE(PG8_SB(0, 0), cB, voffB); PG8_STAGE(PG8_SB(0, 1), cB + hstep, voffB); PG8_STAGE(PG8_SA(0, 0), cA, voffA); PG8_STAGE(PG8_SA(0, 1), cA + hstep, voffA);
        if (wr == 1) PG8_BAR;
        PG8_WAIT_V(2); PG8_BAR;
        PG8_STAGE(PG8_SB(1, 0), cB + kstep, voffB); PG8_STAGE(PG8_SA(1, 0), cA + kstep, voffA); PG8_STAGE(PG8_SB(1, 1), cB + hstep + kstep, voffB);
        PG8_WAIT_V(6); PG8_BAR;
    } else {
        PG8_STAGE(PG8_SB(0, 0), cB, voffB); PG8_STAGE(PG8_SA(0, 0), cA, voffA); PG8_STAGE(PG8_SB(0, 1), cB + hstep, voffB); PG8_STAGE(PG8_SA(0, 1), cA + hstep, voffA);
        if (wr == 1) PG8_BAR;
        PG8_WAIT_V(4); PG8_BAR;
        PG8_STAGE(PG8_SB(1, 0), cB + kstep, voffB); PG8_STAGE(PG8_SA(1, 0), cA + kstep, voffA); PG8_STAGE(PG8_SB(1, 1), cB + hstep + kstep, voffB);
        PG8_WAIT_V(6); PG8_BAR;
    }
    for (;;) {
        const bool has_next = S.next(ui + 1, nxt);
        const char* nA = has_next ? (const char*)g.A + (size_t)nxt.pm * tstep : cA; const char* nB = has_next ? (const char*)g.Bt + (size_t)nxt.pn * tstep : cB;
        for (int t = 0; t < nt; t += 2) {
            const bool last = (t == nt - 2);
            const char* a1 = cA + (size_t)(t + 1) * kstep;
            const char* a2 = last ? nA : cA + (size_t)(t + 2) * kstep; const char* b2 = last ? nB : cB + (size_t)(t + 2) * kstep;
            const char* a3 = a2 + kstep; const char* b3 = b2 + kstep;
            if (last && has_next) S.a_ready(nxt);
            if constexpr (SP2) {
            PG8_LDB(B0, 0, 0); PG8_LDB(B1, 0, 1); PG8_SCHED; PG8_LDA(At, 0, 0); PG8_STAGE(PG8_SA(1, 1), a1 + hstep, voffA);
            PG8_WAIT_V(8); PG8_WAIT_L(0); PG8_BAR; PG8_MMA(0, 0, At, B0); PG8_MMA(0, 1, At, B1); PG8_BAR; PG8_SCHED;
            PG8_LDA(At, 0, 1); PG8_STAGE(PG8_SB(0, 0), b2, voffB); PG8_STAGE(PG8_SB(0, 1), b2 + hstep, voffB); PG8_STAGE(PG8_SA(0, 0), a2, voffA);
            PG8_WAIT_V(8); PG8_WAIT_L(0); PG8_BAR; PG8_MMA(1, 0, At, B0); PG8_MMA(1, 1, At, B1); PG8_BAR; PG8_SCHED;
            PG8_LDB(B0, 1, 0); PG8_LDB(B1, 1, 1); PG8_SCHED; PG8_LDA(At, 1, 0); PG8_STAGE(PG8_SA(0, 1), a2 + hstep, voffA);
            PG8_WAIT_V(8); PG8_WAIT_L(0); PG8_BAR; PG8_MMA(0, 0, At, B0); PG8_MMA(0, 1, At, B1); PG8_BAR; PG8_SCHED;
            PG8_LDA(At, 1, 1); PG8_STAGE(PG8_SB(1, 0), b3, voffB); PG8_STAGE(PG8_SB(1, 1), b3 + hstep, voffB); PG8_STAGE(PG8_SA(1, 0), a3, voffA);
            PG8_WAIT_V(8); PG8_WAIT_L(0); PG8_BAR; PG8_MMA(1, 0, At, B0); PG8_MMA(1, 1, At, B1); PG8_BAR; PG8_SCHED;
            } else {
            PG8_LDB(B0, 0, 0); PG8_SCHED; PG8_LDA(At, 0, 0); PG8_STAGE(PG8_SA(1, 1), a1 + hstep, voffA);
            PG8_WAIT_L(8); PG8_BAR; PG8_WAIT_L(0); PG8_MMA(0, 0, At, B0); PG8_BAR; PG8_SCHED;
            PG8_LDB(B1, 0, 1); PG8_STAGE(PG8_SB(0, 0), b2, voffB);
            PG8_BAR; PG8_WAIT_L(0); PG8_MMA(0, 1, At, B1); PG8_BAR;
            PG8_LDA(At, 0, 1); PG8_STAGE(PG8_SA(0, 0), a2, voffA);
            PG8_BAR; PG8_WAIT_L(0); PG8_MMA(1, 0, At, B0); PG8_BAR; PG8_SCHED;
            PG8_STAGE(PG8_SB(0, 1), b2 + hstep, voffB);
            PG8_WAIT_V(6); PG8_BAR; PG8_MMA(1, 1, At, B1); PG8_BAR;
            PG8_LDB(B0, 1, 0); PG8_SCHED; PG8_LDA(At, 1, 0); PG8_STAGE(PG8_SA(0, 1), a2 + hstep, voffA);
            PG8_WAIT_L(8); PG8_BAR; PG8_WAIT_L(0); PG8_MMA(0, 0, At, B0); PG8_BAR; PG8_SCHED;
            PG8_LDB(B1, 1, 1); PG8_STAGE(PG8_SB(1, 0), b3, voffB);
            PG8_BAR; PG8_WAIT_L(0); PG8_MMA(0, 1, At, B1); PG8_BAR;
            PG8_LDA(At, 1, 1); PG8_STAGE(PG8_SA(1, 0), a3, voffA);
            PG8_BAR; PG8_WAIT_L(0); PG8_MMA(1, 0, At, B0); PG8_BAR; PG8_SCHED;
            PG8_STAGE(PG8_SB(1, 1), b3 + hstep, voffB);
            PG8_WAIT_V(6); PG8_BAR; PG8_MMA(1, 1, At, B1); PG8_BAR;
            }
        }
        if constexpr (ALIGN_EPI) { if (wr == 0) PG8_BAR; }
        if constexpr (!Epi::AFTER_DRAIN) { E(acc, cur, wr, wc, fr, fq); S.done(cur); }
        if (!has_next) break;
#pragma unroll
        for (int a = 0; a < 2; ++a)
#pragma unroll
            for (int b = 0; b < 2; ++b)
#pragma unroll
                for (int m = 0; m < 4; ++m)
#pragma unroll
                    for (int n = 0; n < 2; ++n) acc[a][b][m][n] = (f32x4){0.f, 0.f, 0.f, 0.f};
        cur = nxt; cA = nA; cB = nB; ++ui;
        if constexpr (ALIGN_EPI) { if (wr == 1) PG8_BAR; }
    }
    PG8_WAIT_V(0);
    if constexpr (!ALIGN_EPI) { if (wr == 0) PG8_BAR; }
    PG8_BAR;
    if constexpr (Epi::AFTER_DRAIN) { E.fused(acc, cur, wr, wc, fr, fq, lds, wid, lane); S.done(cur); }
#undef PG8_SA
#undef PG8_SB
#undef PG8_STAGE
#undef PG8_LDA
#undef PG8_LDB
#undef PG8_MMA
#undef PG8_WAIT_V
#undef PG8_WAIT_L
#undef PG8_BAR
#undef PG8_SCHED
}
}
#define GAS __attribute__((address_space(1)))
#define LAS __attribute__((address_space(3)))
typedef unsigned short bf16;
typedef unsigned v4u __attribute__((ext_vector_type(4)));
typedef float f32x4 __attribute__((ext_vector_type(4)));
typedef short bf16x8 __attribute__((ext_vector_type(8)));
typedef GAS unsigned gu32;
typedef GAS unsigned long long gu64;
#define RLX_AGENT __ATOMIC_RELAXED, __HIP_MEMORY_SCOPE_AGENT
#define LDS_WAIT() asm volatile("s_waitcnt lgkmcnt(0)" ::: "memory")
#define VM_WAIT() asm volatile("s_waitcnt vmcnt(0)" ::: "memory")
__device__ __forceinline__ unsigned long long rt() { return __builtin_amdgcn_s_memrealtime(); }
__device__ __forceinline__ unsigned f2bf(float f) { unsigned u = __builtin_bit_cast(unsigned, f); return (u + 0x7fffu + ((u >> 16) & 1u)) >> 16; }
__device__ __forceinline__ unsigned pk2(float lo, float hi) { return f2bf(lo) | (f2bf(hi) << 16); }

#define XB_TMO      128
#define XB_XCNT(j)  (256  + 64 * (j))
#define XB_XSUB(j)  (1280 + 64 * (j))
#define XB_XGEN(j)  (2304 + 64 * (j))
#define XB_TOP      3328
#define XB_TOPGEN   3392
#define XCD_BAR_WORDS 3456
#define XB_SPIN_CAP (1u << 18)

__device__ __forceinline__ unsigned xb_ld(unsigned* p)              { return __hip_atomic_load(p, __ATOMIC_RELAXED, __HIP_MEMORY_SCOPE_AGENT); }
__device__ __forceinline__ unsigned xb_add(unsigned* p, unsigned v) { return __hip_atomic_fetch_add(p, v, __ATOMIC_RELAXED, __HIP_MEMORY_SCOPE_AGENT); }
__device__ __forceinline__ unsigned xb_xcc_id() { return (unsigned)__builtin_amdgcn_s_getreg((3 << 11) | 20) & 0xFu; }
#define XB_SPIN(cond, bar) do { unsigned _sp = 0; while (cond) { __builtin_amdgcn_s_sleep(1); \
    if ((++_sp & 255u) == 0u) { if (xb_ld(&(bar)[XB_TMO])) break; if (_sp > XB_SPIN_CAP) { atomicAdd(&(bar)[XB_TMO], 1u); break; } } } } while (0)

struct XcdBarrier {
    unsigned* bar; unsigned x;
    volatile LAS unsigned* st;
};

__device__ __forceinline__ XcdBarrier xcd_barrier_post(unsigned* bar, volatile LAS unsigned* st) {
    XcdBarrier b; b.bar = bar; b.x = xb_xcc_id(); b.st = st;
    if (threadIdx.x == 0) (void)xb_add(&bar[XB_XCNT(b.x)], 1u);
    return b;
}
__device__ __forceinline__ void xcd_barrier_complete(unsigned* bar, unsigned x, unsigned& nloc, unsigned& nx) {
    const unsigned G = gridDim.x * gridDim.y * gridDim.z;
    unsigned sum, cnt, mine, sp = 0u;
    for (;;) {
        sum = 0u; cnt = 0u; mine = 0u;
#pragma unroll
        for (unsigned j = 0; j < 16; ++j) { const unsigned c = xb_ld(&bar[XB_XCNT(j)]); sum += c; cnt += (c > 0u) ? 1u : 0u; mine = (j == x) ? c : mine; }
        if (sum == G) break;
        __builtin_amdgcn_s_sleep(1);
        if ((++sp & 255u) == 0u) { if (xb_ld(&bar[XB_TMO])) break; if (sp > XB_SPIN_CAP) { atomicAdd(&bar[XB_TMO], 1u); break; } }
    }
    nloc = mine > 0u ? mine : 1u; nx = cnt > 0u ? cnt : 1u;
}

__device__ __forceinline__ void xcd_barrier(const XcdBarrier& b) {
    asm volatile("s_waitcnt vmcnt(0)" ::: "memory");
    __syncthreads();
    if (threadIdx.x == 0) {
        unsigned* bar = b.bar;
        __builtin_amdgcn_s_waitcnt(0);
        unsigned nloc = b.st[0], nx = b.st[1];
        if (nloc == 0u) { xcd_barrier_complete(bar, b.x, nloc, nx); b.st[0] = nloc; b.st[1] = nx; }
        const unsigned old = xb_add(&bar[XB_XSUB(b.x)], 1u);
        const unsigned gen = old / nloc;
        if (old + 1u == (gen + 1u) * nloc) {
            __builtin_amdgcn_fence(__ATOMIC_RELEASE, "agent");
            asm volatile("s_waitcnt vmcnt(0)" ::: "memory");
            const unsigned og = xb_add(&bar[XB_TOP], 1u);
            const unsigned tg = og / nx;
            if (og + 1u == (tg + 1u) * nx) xb_add(&bar[XB_TOPGEN], 1u);
            else XB_SPIN(xb_ld(&bar[XB_TOPGEN]) == tg, bar);
            __builtin_amdgcn_fence(__ATOMIC_ACQUIRE, "agent");
            xb_add(&bar[XB_XGEN(b.x)], 1u);
            asm volatile("s_waitcnt vmcnt(0)" ::: "memory");
        } else {
            XB_SPIN(xb_ld(&bar[XB_XGEN(b.x)]) == gen, bar);
            __builtin_amdgcn_fence(__ATOMIC_ACQUIRE, "agent");
            asm volatile("s_waitcnt vmcnt(0)" ::: "memory");
        }
    }
    __syncthreads();
}
constexpr int DM = 1024, NBATCH = 8, SEQ = 4096, MP = NBATCH * SEQ, NSS = 128, TS = 8, MS = NSS * TS, M = MP + MS;
constexpr int NPROJ = 2304, IN_DIM = 2312, DFF = 2816, NMEM = 256, CA = 512;
constexpr int PZ = 0, PXBC = 512, PQ = 1536, PK = 2048, PV = 2176;
constexpr float EPS = 1e-6f;
constexpr int NWAVES = 8;
constexpr size_t O_Y = 0, O_PCONV = 34603008, O_PSSM = 34627584, O_PSWAK = 35151872, O_PSWAV = 35282944, O_PMEMK = 35414016, O_PMEMV = 36462592,
                 O_SCONV = 37511168, O_SSSM = 37904384, O_SSWAK = 46292992, O_SSWAV = 48390144, O_END = 50487296;
constexpr size_t MiB = 1u << 20;
constexpr size_t WS_CTL = 0, CTL_ZERO_BYTES = 1 * MiB;
constexpr size_t WS_WIN = 2 * MiB, WS_WOUT = 7 * MiB, WS_WCQ = 9 * MiB, WS_WCKV = 10 * MiB, WS_WCO = 12 * MiB, WS_WGU = 13 * MiB, WS_WD = 24 * MiB;
constexpr size_t WS_DT = 30 * MiB, WS_SSQ1 = 32 * MiB, WS_SSQ2 = 35 * MiB, WS_SSQ3 = 38 * MiB, WS_MN = 41 * MiB, WS_MKVB = 45 * MiB;
constexpr size_t WS_R1 = 50 * MiB;
constexpr size_t WS_R2 = 116 * MiB;
constexpr size_t WS_R3 = 298 * MiB;
constexpr size_t WS_YS = 364 * MiB;
constexpr size_t WS_HB = 430 * MiB;
constexpr size_t WS_END = 496 * MiB;
constexpr int CW_BAR = 4096;
constexpr int RING_OFF = 0, RING_BYTES = 131072, LDSCTL_OFF = RING_BYTES, MISC_OFF = LDSCTL_OFF + 320, LDS_BYTES = 147456;

__device__ __forceinline__ float bf2f(unsigned short b) { return __uint_as_float((unsigned)b << 16); }
__device__ __forceinline__ float bflo(unsigned w) { return __uint_as_float(w << 16); }
__device__ __forceinline__ float bfhi(unsigned w) { return __uint_as_float(w & 0xffff0000u); }
__device__ __forceinline__ float wave_sum(float v) {
#pragma unroll
    for (int o = 1; o < 64; o <<= 1) v += __shfl_xor(v, o);
    return v;
}
__device__ __forceinline__ float wave_max(float v) {
#pragma unroll
    for (int o = 1; o < 64; o <<= 1) v = fmaxf(v, __shfl_xor(v, o));
    return v;
}
__device__ __forceinline__ float silu(float x) { return x / (1.0f + __expf(-x)); }
__device__ __forceinline__ float softplus(float x) { return fmaxf(x, 0.f) + log1pf(__expf(-fabsf(x))); }
__device__ __forceinline__ int t5_bucket(int n) { if (n < 16) return n; int l = 16 + (int)(logf((float)n * (1.0f / 16.0f)) / logf(8.0f) * 16.0f); return l < 31 ? l : 31; }

struct Frame {
    LAS unsigned char* lds;
    volatile LAS unsigned* MISC;
    gu32* ctl;
    int tid, lane, wave, vcu, G;
    const float* in[31];
    float* out;
    bf16 *Win_t, *Wout_t, *Wcq_t, *Wckv_t, *Wco_t, *Wgu_t, *Wd_t;
    float *DT, *SSQ1, *SSQ2, *SSQ3, *YS;
    bf16 *MN, *MKVB, *XN, *MIX, *PROJ, *HM, *XC, *QC, *OC, *HB;
};
enum { I_XP = 0, I_XS, I_MEMP, I_SCONV, I_SSSM, I_CSWAK, I_CSWAV, I_CMEMK, I_CMEMV, I_RELB, I_GMIX, I_WIN, I_CONVW, I_CONVB, I_DTB, I_ALOG, I_DSKIP, I_GSSD, I_SINKS, I_WOUT,
       I_GCROSS, I_GMEM, I_WCQ, I_WCK, I_WCV, I_WCO, I_GFFN, I_WGATE, I_WUP, I_WDOWN, I_GFINAL };

__device__ __forceinline__ void p0_transpose_item(const float* W, int ldw, int src_col0, int K, bf16* WT, int dst_row0, const float* gk, LAS float* scr, int kb, int lane) {
    const int k0 = 64 * kb;
#pragma unroll 8
    for (int i = 0; i < 32; ++i) { const int kk = 2 * i + (lane >> 5); float v = W[(size_t)(k0 + kk) * ldw + src_col0 + (lane & 31)]; if (gk) v *= gk[k0 + kk]; scr[kk * 33 + (lane & 31)] = v; }
    LDS_WAIT(); asm volatile("" ::: "memory");
    const int c = lane & 7;
#pragma unroll
    for (int j = 0; j < 4; ++j) { const int n = (lane >> 3) + 8 * j; const LAS float* s = scr + (8 * c) * 33 + n;
        v4u o; o.x = pk2(s[0 * 33], s[1 * 33]); o.y = pk2(s[2 * 33], s[3 * 33]); o.z = pk2(s[4 * 33], s[5 * 33]); o.w = pk2(s[6 * 33], s[7 * 33]);
        *(GAS v4u*)(WT + (size_t)(dst_row0 + n) * K + k0 + 8 * c) = o; }
    LDS_WAIT(); asm volatile("" ::: "memory");
}
__device__ __forceinline__ void p0_norm_row(const float* xrow, const float* g, bf16* orow, float* dtout, const LAS float* wdtT, int lane) {
    const GAS f32x4* xr = (const GAS f32x4*)xrow + lane; const GAS f32x4* gr = (const GAS f32x4*)g + lane;
    f32x4 v[4]; float s = 0.f;
#pragma unroll
    for (int j = 0; j < 4; ++j) { v[j] = xr[64 * j]; s += (v[j].x * v[j].x + v[j].y * v[j].y) + (v[j].z * v[j].z + v[j].w * v[j].w); }
    const float rstd = 1.0f / sqrtf(wave_sum(s) * (1.f / DM) + EPS);
#pragma unroll
    for (int j = 0; j < 4; ++j) v[j] = v[j] * rstd * gr[64 * j];
    GAS unsigned long long* o8 = (GAS unsigned long long*)orow + lane;
#pragma unroll
    for (int j = 0; j < 4; ++j) o8[64 * j] = (unsigned long long)pk2(v[j].x, v[j].y) | ((unsigned long long)pk2(v[j].z, v[j].w) << 32);
    if (dtout) {
        float a[8];
#pragma unroll
        for (int h = 0; h < 8; ++h) { float acc = 0.f;
#pragma unroll
            for (int j = 0; j < 4; ++j) { const f32x4 w = *(const LAS f32x4*)(wdtT + h * 1024 + 256 * j + 4 * lane); acc += (v[j].x * w.x + v[j].y * w.y) + (v[j].z * w.z + v[j].w * w.w); }
            a[h] = wave_sum(acc); }
        if (lane == 0) { *(f32x4*)(dtout) = (f32x4){a[0], a[1], a[2], a[3]}; *(f32x4*)(dtout + 4) = (f32x4){a[4], a[5], a[6], a[7]}; }
    }
}
__device__ __forceinline__ void p0_prologue(const Frame& F) {
    LAS float* wdtT = (LAS float*)(F.lds + RING_OFF);
    LAS float* scr = (LAS float*)(F.lds + RING_OFF + 32768 + F.wave * 12288);
    const float* w_in = F.in[I_WIN];
    for (int idx = F.tid; idx < 8192; idx += NWAVES * 64) { const int h = idx >> 10, k = idx & 1023; wdtT[idx] = w_in[(size_t)k * IN_DIM + 1536 + h]; }
    __syncthreads();
    const int gw = F.vcu * NWAVES + F.wave, NGW = F.G * NWAVES;
    constexpr int I1 = 72 * 16, I2 = 32 * 16, I3 = 16 * 16, I4 = 32 * 16, I5 = 32 * 8, I6 = 176 * 16, I7 = 32 * 44, NITEMS = I1 + I2 + I3 + I4 + I5 + I6 + I7;
    for (int it = gw; it < NITEMS; it += NGW) {
        int r = it;
        if (r < I1) { const int nb = r / 16, kb = r % 16, d0 = 32 * nb; p0_transpose_item(w_in, IN_DIM, d0 < 1536 ? d0 : d0 + 8, DM, F.Win_t, d0, nullptr, scr, kb, F.lane); continue; } r -= I1;
        if (r < I2) { const int nb = r / 16, kb = r % 16; p0_transpose_item(F.in[I_WOUT], DM, 32 * nb, DM, F.Wout_t, 32 * nb, nullptr, scr, kb, F.lane); continue; } r -= I2;
        if (r < I3) { const int nb = r / 16, kb = r % 16; p0_transpose_item(F.in[I_WCQ], CA, 32 * nb, DM, F.Wcq_t, 32 * nb, F.in[I_GCROSS], scr, kb, F.lane); continue; } r -= I3;
        if (r < I4) { const int nb = r / 16, kb = r % 16, d0 = 32 * nb; p0_transpose_item(d0 < 512 ? F.in[I_WCK] : F.in[I_WCV], CA, d0 & 511, DM, F.Wckv_t, d0, nullptr, scr, kb, F.lane); continue; } r -= I4;
        if (r < I5) { const int nb = r / 8, kb = r % 8; p0_transpose_item(F.in[I_WCO], DM, 32 * nb, CA, F.Wco_t, 32 * nb, nullptr, scr, kb, F.lane); continue; } r -= I5;
        if (r < I6) { const int nb = r / 16, kb = r % 16, d0 = 32 * nb, tile = d0 >> 8, within = d0 & 255;
            p0_transpose_item(within < 128 ? F.in[I_WGATE] : F.in[I_WUP], DFF, tile * 128 + (within & 127), DM, F.Wgu_t, d0, F.in[I_GFFN], scr, kb, F.lane); continue; } r -= I6;
        { const int nb = r / 44, kb = r % 44; p0_transpose_item(F.in[I_WDOWN], DM, 32 * nb, DFF, F.Wd_t, 32 * nb, nullptr, scr, kb, F.lane); }
    }
    for (int m = gw; m < M; m += NGW) {
        const float* xrow = m < MP ? F.in[I_XP] + (size_t)m * DM : F.in[I_XS] + (size_t)(m - MP) * DM;
        p0_norm_row(xrow, F.in[I_GMIX], F.XN + (size_t)m * DM, F.DT + (size_t)m * 8, wdtT, F.lane);
    }
    for (int m = gw; m < NBATCH * NMEM; m += NGW) p0_norm_row(F.in[I_MEMP] + (size_t)m * DM, F.in[I_GMEM], F.MN + (size_t)m * DM, nullptr, wdtT, F.lane);
}

__device__ __forceinline__ void n1_conv(const Frame& F) {
    const int gw = F.vcu * NWAVES + F.wave, NGW = F.G * NWAVES, lane = F.lane;
    const float* cw = F.in[I_CONVW]; const float* cb = F.in[I_CONVB];
    for (int m = gw; m < M; m += NGW) {
        const bool samp = m >= MP; int t, L, seq;
        if (!samp) { seq = m / SEQ; t = m % SEQ; L = SEQ; } else { const int r = m - MP; seq = r / TS; t = r % TS; L = TS; }
        const float* hist = F.in[I_SCONV] + (size_t)seq * 3 * 1024;
#pragma unroll
        for (int j2 = 0; j2 < 2; ++j2) {
            const int c = 8 * lane + 512 * j2;
            float acc[8];
            { const f32x4 b0 = *(const f32x4*)(cb + c), b1 = *(const f32x4*)(cb + c + 4); acc[0] = b0.x; acc[1] = b0.y; acc[2] = b0.z; acc[3] = b0.w; acc[4] = b1.x; acc[5] = b1.y; acc[6] = b1.z; acc[7] = b1.w; }
            v4u raw_last = (v4u){0u, 0u, 0u, 0u};
#pragma unroll
            for (int k = 0; k < 4; ++k) {
                const int tt = t - 3 + k; float xv[8];
                if (tt >= 0) { const v4u raw = *(const v4u*)(F.PROJ + (size_t)(m - 3 + k) * NPROJ + PXBC + c);
                    xv[0] = bflo(raw.x); xv[1] = bfhi(raw.x); xv[2] = bflo(raw.y); xv[3] = bfhi(raw.y); xv[4] = bflo(raw.z); xv[5] = bfhi(raw.z); xv[6] = bflo(raw.w); xv[7] = bfhi(raw.w);
                    if (k == 3) raw_last = raw; }
                else if (samp) { const f32x4 h0 = *(const f32x4*)(hist + (size_t)(tt + 3) * 1024 + c), h1 = *(const f32x4*)(hist + (size_t)(tt + 3) * 1024 + c + 4);
                    xv[0] = h0.x; xv[1] = h0.y; xv[2] = h0.z; xv[3] = h0.w; xv[4] = h1.x; xv[5] = h1.y; xv[6] = h1.z; xv[7] = h1.w; }
                else {
#pragma unroll
                    for (int e = 0; e < 8; ++e) xv[e] = 0.f; }
                const f32x4 w0 = *(const f32x4*)(cw + k * 1024 + c), w1 = *(const f32x4*)(cw + k * 1024 + c + 4);
                acc[0] += xv[0] * w0.x; acc[1] += xv[1] * w0.y; acc[2] += xv[2] * w0.z; acc[3] += xv[3] * w0.w; acc[4] += xv[4] * w1.x; acc[5] += xv[5] * w1.y; acc[6] += xv[6] * w1.z; acc[7] += xv[7] * w1.w;
            }
#pragma unroll
            for (int e = 0; e < 8; ++e) acc[e] = silu(acc[e]);
            v4u o; o.x = pk2(acc[0], acc[1]); o.y = pk2(acc[2], acc[3]); o.z = pk2(acc[4], acc[5]); o.w = pk2(acc[6], acc[7]);
            *(v4u*)(F.XC + (size_t)m * 1024 + c) = o;
            if (t >= L - 3) {
                const int j = t - (L - 3);
                float* dst = F.out + (samp ? O_SCONV : O_PCONV) + ((size_t)seq * 3 + j) * 1024 + c;
                *(f32x4*)dst = (f32x4){bflo(raw_last.x), bfhi(raw_last.x), bflo(raw_last.y), bfhi(raw_last.y)};
                *(f32x4*)(dst + 4) = (f32x4){bflo(raw_last.z), bfhi(raw_last.z), bflo(raw_last.w), bfhi(raw_last.w)};
            }
        }
    }
    for (int it = gw; it < NBATCH * 128 + NSS * 128; it += NGW) {
        const int c = 2 * lane;
        if (it < NBATCH * 128) { const int b = it >> 7, j = it & 127; const size_t src = (size_t)(b * SEQ + SEQ - 128 + j) * NPROJ;
            const unsigned kw = *(const unsigned*)(F.PROJ + src + PK + c), vw = *(const unsigned*)(F.PROJ + src + PV + c);
            float* ok = F.out + O_PSWAK + (size_t)it * 128 + c; float* ov = F.out + O_PSWAV + (size_t)it * 128 + c;
            ok[0] = bflo(kw); ok[1] = bfhi(kw); ov[0] = bflo(vw); ov[1] = bfhi(vw); }
        else { const int r = it - NBATCH * 128, s = r >> 7, j = r & 127; float* ok = F.out + O_SSWAK + (size_t)r * 128 + c; float* ov = F.out + O_SSWAV + (size_t)r * 128 + c;
            if (j < 120) { const size_t src = ((size_t)s * 128 + j + 8) * 128 + c; ok[0] = F.in[I_CSWAK][src]; ok[1] = F.in[I_CSWAK][src + 1]; ov[0] = F.in[I_CSWAV][src]; ov[1] = F.in[I_CSWAV][src + 1]; }
            else { const size_t src = (size_t)(MP + s * TS + j - 120) * NPROJ; const unsigned kw = *(const unsigned*)(F.PROJ + src + PK + c), vw = *(const unsigned*)(F.PROJ + src + PV + c);
                ok[0] = bflo(kw); ok[1] = bfhi(kw); ov[0] = bflo(vw); ov[1] = bfhi(vw); } }
    }
}

struct SsdStep { v4u b0, b1, c0, c1; float dtr; unsigned short xr; };
__device__ __forceinline__ void n2_load(SsdStep& s, const bf16* XC, const float* DT, size_t m, int h, int p, int g, int nq) {
    const bf16* row = XC + m * 1024;
    s.b0 = *(const v4u*)(row + 512 + g * 128 + nq * 16); s.b1 = *(const v4u*)(row + 512 + g * 128 + nq * 16 + 8);
    s.c0 = *(const v4u*)(row + 768 + g * 128 + nq * 16); s.c1 = *(const v4u*)(row + 768 + g * 128 + nq * 16 + 8);
    s.dtr = DT[m * 8 + h]; s.xr = row[h * 64 + p];
}
__device__ __forceinline__ void n2_step(const SsdStep& s, float (&st)[16], float A, float dtb, float dsk, float* YS, size_t m, int h, int p, int nq) {
    const float xv = bf2f(s.xr), dt = softplus(s.dtr + dtb), dA = __expf(dt * A), dx = dt * xv;
    const unsigned bw[8] = {s.b0.x, s.b0.y, s.b0.z, s.b0.w, s.b1.x, s.b1.y, s.b1.z, s.b1.w};
    const unsigned cw[8] = {s.c0.x, s.c0.y, s.c0.z, s.c0.w, s.c1.x, s.c1.y, s.c1.z, s.c1.w};
    float y = 0.f;
#pragma unroll
    for (int i = 0; i < 8; ++i) {
        st[2 * i] = dA * st[2 * i] + dx * bflo(bw[i]); st[2 * i + 1] = dA * st[2 * i + 1] + dx * bfhi(bw[i]);
        y += st[2 * i] * bflo(cw[i]) + st[2 * i + 1] * bfhi(cw[i]);
    }
    y += __shfl_xor(y, 1); y += __shfl_xor(y, 2); y += __shfl_xor(y, 4);
    if (nq == 0) YS[m * 512 + h * 64 + p] = y + dsk * xv;
}
__device__ __forceinline__ void n2_ssd(const Frame& F) {
    const int gw = F.vcu * NWAVES + F.wave, NGW = F.G * NWAVES, lane = F.lane;
    const int NIT = (NBATCH + NSS) * 64;
    for (int it = gw; it < NIT; it += NGW) {
        const int seq = it >> 6, h = (it >> 3) & 7, pg = it & 7, pl = lane >> 3, nq = lane & 7, p = pg * 8 + pl, g = h >> 2;
        const bool samp = seq >= NBATCH; const int T = samp ? TS : SEQ; const size_t m0 = samp ? (size_t)MP + (size_t)(seq - NBATCH) * TS : (size_t)seq * SEQ;
        float st[16];
        if (samp) { const float* s0 = F.in[I_SSSM] + (((size_t)(seq - NBATCH) * 8 + h) * 64 + p) * 128 + nq * 16;
#pragma unroll
            for (int i = 0; i < 4; ++i) { const f32x4 v = *(const f32x4*)(s0 + 4 * i); st[4 * i] = v.x; st[4 * i + 1] = v.y; st[4 * i + 2] = v.z; st[4 * i + 3] = v.w; } }
        else {
#pragma unroll
            for (int i = 0; i < 16; ++i) st[i] = 0.f; }
        const float A = -__expf(F.in[I_ALOG][h]), dtb = F.in[I_DTB][h], dsk = F.in[I_DSKIP][h];
        SsdStep c0, c1, c2, c3, n0, n1, n2, n3;
        n2_load(c0, F.XC, F.DT, m0 + 0, h, p, g, nq); n2_load(c1, F.XC, F.DT, m0 + 1, h, p, g, nq); n2_load(c2, F.XC, F.DT, m0 + 2, h, p, g, nq); n2_load(c3, F.XC, F.DT, m0 + 3, h, p, g, nq);
        for (int t = 0; t < T; t += 4) {
            const size_t m = m0 + t; const size_t mn = (t + 4 < T) ? m + 4 : m;
            n2_load(n0, F.XC, F.DT, mn + 0, h, p, g, nq); n2_load(n1, F.XC, F.DT, mn + 1, h, p, g, nq); n2_load(n2, F.XC, F.DT, mn + 2, h, p, g, nq); n2_load(n3, F.XC, F.DT, mn + 3, h, p, g, nq);
            n2_step(c0, st, A, dtb, dsk, F.YS, m + 0, h, p, nq); n2_step(c1, st, A, dtb, dsk, F.YS, m + 1, h, p, nq);
            n2_step(c2, st, A, dtb, dsk, F.YS, m + 2, h, p, nq); n2_step(c3, st, A, dtb, dsk, F.YS, m + 3, h, p, nq);
            c0 = n0; c1 = n1; c2 = n2; c3 = n3;
        }
        float* so = F.out + (samp ? O_SSSM + (((size_t)(seq - NBATCH) * 8 + h) * 64 + p) * 128 : O_PSSM + (((size_t)seq * 8 + h) * 64 + p) * 128) + nq * 16;
#pragma unroll
        for (int i = 0; i < 4; ++i) *(f32x4*)(so + 4 * i) = (f32x4){st[4 * i], st[4 * i + 1], st[4 * i + 2], st[4 * i + 3]};
    }
}

__device__ __forceinline__ void n3_gate(const Frame& F) {
    const int gw = F.vcu * NWAVES + F.wave, NGW = F.G * NWAVES, lane = F.lane, c = 8 * lane;
    const float* gn = F.in[I_GSSD];
    for (int m = gw; m < M; m += NGW) {
        const f32x4 y0 = *(const f32x4*)(F.YS + (size_t)m * 512 + c), y1 = *(const f32x4*)(F.YS + (size_t)m * 512 + c + 4);
        const v4u zr = *(const v4u*)(F.PROJ + (size_t)m * NPROJ + PZ + c);
        float v[8] = {y0.x, y0.y, y0.z, y0.w, y1.x, y1.y, y1.z, y1.w};
        const float z[8] = {bflo(zr.x), bfhi(zr.x), bflo(zr.y), bfhi(zr.y), bflo(zr.z), bfhi(zr.z), bflo(zr.w), bfhi(zr.w)};
        float ss = 0.f;
#pragma unroll
        for (int e = 0; e < 8; ++e) { v[e] = v[e] * silu(z[e]); ss += v[e] * v[e]; }
#pragma unroll
        for (int o = 1; o < 32; o <<= 1) ss += __shfl_xor(ss, o);
        const float rs = 1.0f / sqrtf(ss * (1.0f / 256.0f) + EPS);
        const f32x4 g0 = *(const f32x4*)(gn + c), g1 = *(const f32x4*)(gn + c + 4);
        v4u o; o.x = pk2(v[0] * rs * g0.x, v[1] * rs * g0.y); o.y = pk2(v[2] * rs * g0.z, v[3] * rs * g0.w); o.z = pk2(v[4] * rs * g1.x, v[5] * rs * g1.y); o.w = pk2(v[6] * rs * g1.z, v[7] * rs * g1.w);
        *(v4u*)(F.MIX + (size_t)m * 1024 + c) = o;
    }
}

__device__ __forceinline__ void n4_swa(const Frame& F) {
    const int gw = F.vcu * NWAVES + F.wave, NGW = F.G * NWAVES, lane = F.lane;
    const float* relb = F.in[I_RELB]; const float* sinks = F.in[I_SINKS];
    for (int it = gw; it < M * 8; it += NGW) {
        const int m = it >> 3, head = it & 7, kv = head >> 2;
        const bool samp = m >= MP; int t, seq;
        if (!samp) { seq = m / SEQ; t = m % SEQ; } else { const int r = m - MP; seq = r / TS; t = r % TS; }
        v4u q[8];
#pragma unroll
        for (int i = 0; i < 8; ++i) q[i] = *(const v4u*)(F.PROJ + (size_t)m * NPROJ + PQ + head * 64 + 8 * i);
        float sc[2];
#pragma unroll
        for (int hh = 0; hh < 2; ++hh) {
            const int dist = lane + 64 * hh, tk = t - dist; float dot = 0.f; bool valid = true;
            if (tk >= 0) { const bf16* kr = F.PROJ + (size_t)(m - dist) * NPROJ + PK + kv * 64;
#pragma unroll
                for (int i = 0; i < 8; ++i) { const v4u k8 = *(const v4u*)(kr + 8 * i);
                    dot += bflo(q[i].x) * bflo(k8.x) + bfhi(q[i].x) * bfhi(k8.x) + bflo(q[i].y) * bflo(k8.y) + bfhi(q[i].y) * bfhi(k8.y)
                         + bflo(q[i].z) * bflo(k8.z) + bfhi(q[i].z) * bfhi(k8.z) + bflo(q[i].w) * bflo(k8.w) + bfhi(q[i].w) * bfhi(k8.w); } }
            else if (samp) { const float* kr = F.in[I_CSWAK] + (((size_t)seq * 128 + (128 + tk)) * 2 + kv) * 64;
#pragma unroll
                for (int i = 0; i < 8; ++i) { const f32x4 k0 = *(const f32x4*)(kr + 8 * i), k1 = *(const f32x4*)(kr + 8 * i + 4);
                    dot += bflo(q[i].x) * k0.x + bfhi(q[i].x) * k0.y + bflo(q[i].y) * k0.z + bfhi(q[i].y) * k0.w + bflo(q[i].z) * k1.x + bfhi(q[i].z) * k1.y + bflo(q[i].w) * k1.z + bfhi(q[i].w) * k1.w; } }
            else valid = false;
            sc[hh] = valid ? dot * 0.125f + relb[t5_bucket(dist) * 8 + head] : -INFINITY;
        }
        const float sk = sinks[head];
        const float mx = fmaxf(wave_max(fmaxf(sc[0], sc[1])), sk);
        const float p0 = __expf(sc[0] - mx), p1 = __expf(sc[1] - mx);
        const float den = wave_sum(p0 + p1) + __expf(sk - mx);
        float acc = 0.f;
        const int nd = samp ? 128 : (t + 1 < 128 ? t + 1 : 128);
        for (int dist = 0; dist < nd; ++dist) {
            const float p = __shfl(dist < 64 ? p0 : p1, dist & 63); const int tk = t - dist; float v;
            if (tk >= 0) v = bf2f(F.PROJ[(size_t)(m - dist) * NPROJ + PV + kv * 64 + lane]);
            else v = F.in[I_CSWAV][(((size_t)seq * 128 + (128 + tk)) * 2 + kv) * 64 + lane];
            acc += p * v;
        }
        F.MIX[(size_t)m * 1024 + 512 + head * 64 + lane] = (bf16)f2bf(acc / den);
    }
}

__device__ __forceinline__ void n5_cross(const Frame& F) {
    const int gw = F.vcu * NWAVES + F.wave, NGW = F.G * NWAVES, lane = F.lane;
    LAS unsigned* qs = (LAS unsigned*)(F.lds + RING_OFF + F.wave * 2048);
    LAS float* ps = (LAS float*)(F.lds + RING_OFF + F.wave * 2048 + 256);
    for (int it = gw; it < M * 4; it += NGW) {
        const int m = it >> 2, head = it & 3; const bool samp = m >= MP; const int seq = samp ? (m - MP) / TS : m / SEQ;
        qs[lane] = *(const unsigned*)(F.QC + (size_t)m * CA + head * 128 + 2 * lane);
        LDS_WAIT(); asm volatile("" ::: "memory");
        float sc[4];
#pragma unroll
        for (int i = 0; i < 4; ++i) { const int j = lane + 64 * i; float dot = 0.f;
            if (!samp) { const bf16* kr = F.MKVB + (size_t)(seq * NMEM + j) * 1024 + head * 128;
#pragma unroll
                for (int c8 = 0; c8 < 16; ++c8) { const v4u q8 = *(const LAS v4u*)(qs + 4 * c8); const v4u k8 = *(const v4u*)(kr + 8 * c8);
                    dot += bflo(q8.x) * bflo(k8.x) + bfhi(q8.x) * bfhi(k8.x) + bflo(q8.y) * bflo(k8.y) + bfhi(q8.y) * bfhi(k8.y)
                         + bflo(q8.z) * bflo(k8.z) + bfhi(q8.z) * bfhi(k8.z) + bflo(q8.w) * bflo(k8.w) + bfhi(q8.w) * bfhi(k8.w); } }
            else { const float* kr = F.in[I_CMEMK] + (((size_t)seq * NMEM + j) * 4 + head) * 128;
#pragma unroll
                for (int c8 = 0; c8 < 16; ++c8) { const v4u q8 = *(const LAS v4u*)(qs + 4 * c8); const f32x4 k0 = *(const f32x4*)(kr + 8 * c8), k1 = *(const f32x4*)(kr + 8 * c8 + 4);
                    dot += bflo(q8.x) * k0.x + bfhi(q8.x) * k0.y + bflo(q8.y) * k0.z + bfhi(q8.y) * k0.w + bflo(q8.z) * k1.x + bfhi(q8.z) * k1.y + bflo(q8.w) * k1.z + bfhi(q8.w) * k1.w; } }
            sc[i] = dot; }
        const float mx = wave_max(fmaxf(fmaxf(sc[0], sc[1]), fmaxf(sc[2], sc[3])));
        float psum = 0.f;
#pragma unroll
        for (int i = 0; i < 4; ++i) { const float p = __expf(sc[i] - mx); ps[lane + 64 * i] = p; psum += p; }
        const float den = wave_sum(psum);
        LDS_WAIT(); asm volatile("" ::: "memory");
        float a0 = 0.f, a1 = 0.f;
        if (!samp) { const bf16* vr = F.MKVB + (size_t)(seq * NMEM) * 1024 + 512 + head * 128 + 2 * lane;
#pragma unroll 8
            for (int j = 0; j < NMEM; ++j) { const float p = ps[j]; const unsigned w = *(const unsigned*)(vr + (size_t)j * 1024); a0 += p * bflo(w); a1 += p * bfhi(w); } }
        else { const float* vr = F.in[I_CMEMV] + ((size_t)seq * NMEM * 4 + head) * 128 + 2 * lane;
#pragma unroll 8
            for (int j = 0; j < NMEM; ++j) { const float p = ps[j]; const float v0 = vr[(size_t)j * 512], v1 = vr[(size_t)j * 512 + 1]; a0 += p * v0; a1 += p * v1; } }
        const float inv = 1.0f / den;
        *(unsigned*)(F.OC + (size_t)m * CA + head * 128 + 2 * lane) = pk2(a0 * inv, a1 * inv);
        LDS_WAIT(); asm volatile("" ::: "memory");
    }
}

__device__ __forceinline__ void p11_final(const Frame& F) {
    const int gw = F.vcu * NWAVES + F.wave, NGW = F.G * NWAVES, lane = F.lane;
    const GAS f32x4* gr = (const GAS f32x4*)F.in[I_GFINAL] + lane;
    for (int m = gw; m < M; m += NGW) {
        GAS f32x4* xr = (GAS f32x4*)(F.out + O_Y + (size_t)m * DM) + lane;
        f32x4 v[4]; float s = 0.f;
#pragma unroll
        for (int j = 0; j < 4; ++j) { v[j] = xr[64 * j]; s += (v[j].x * v[j].x + v[j].y * v[j].y) + (v[j].z * v[j].z + v[j].w * v[j].w); }
        const float rstd = 1.0f / sqrtf(wave_sum(s) * (1.f / DM) + EPS);
#pragma unroll
        for (int j = 0; j < 4; ++j) xr[64 * j] = v[j] * rstd * gr[64 * j];
    }
}

#ifndef MK_N_LAUNCHES
#define MK_N_LAUNCHES 12
#endif
constexpr int NPH = 12;
constexpr int N_LAUNCHES = MK_N_LAUNCHES;
struct Args { const float* in[31]; float* out; unsigned char* ws; int ph_lo, ph_hi, li, pad; };
__global__ void __launch_bounds__(NWAVES * 64, 2) skel_fwd(Args args) {
    extern __shared__ __attribute__((aligned(16))) unsigned char lds[];
    Frame F;
    F.lds = (LAS unsigned char*)lds;
    F.MISC = (volatile LAS unsigned*)(F.lds + MISC_OFF);
    F.tid = threadIdx.x; F.lane = F.tid & 63; F.wave = __builtin_amdgcn_readfirstlane(F.tid >> 6);
    F.G = gridDim.x; { const int bx = blockIdx.x; F.vcu = (F.G % 8 == 0) ? (bx % 8) * (F.G / 8) + bx / 8 : bx; }
    unsigned char* ws = args.ws;
    F.ctl = (gu32*)(ws + WS_CTL);
#pragma unroll
    for (int i = 0; i < 31; ++i) F.in[i] = args.in[i];
    F.out = args.out;
    F.Win_t = (bf16*)(ws + WS_WIN); F.Wout_t = (bf16*)(ws + WS_WOUT); F.Wcq_t = (bf16*)(ws + WS_WCQ); F.Wckv_t = (bf16*)(ws + WS_WCKV); F.Wco_t = (bf16*)(ws + WS_WCO);
    F.Wgu_t = (bf16*)(ws + WS_WGU); F.Wd_t = (bf16*)(ws + WS_WD);
    F.DT = (float*)(ws + WS_DT); F.SSQ1 = (float*)(ws + WS_SSQ1); F.SSQ2 = (float*)(ws + WS_SSQ2); F.SSQ3 = (float*)(ws + WS_SSQ3); F.YS = (float*)(ws + WS_YS);
    F.MN = (bf16*)(ws + WS_MN); F.MKVB = (bf16*)(ws + WS_MKVB); F.XN = (bf16*)(ws + WS_R1); F.MIX = (bf16*)(ws + WS_R1); F.PROJ = (bf16*)(ws + WS_R2); F.HM = (bf16*)(ws + WS_R2);
    F.XC = (bf16*)(ws + WS_R3); F.QC = (bf16*)(ws + WS_R3); F.OC = (bf16*)(ws + WS_R3 + 33 * MiB); F.HB = (bf16*)(ws + WS_HB);
    for (int u = F.tid; u < (LDS_BYTES - LDSCTL_OFF) / 4; u += NWAVES * 64) ((LAS unsigned*)(F.lds + LDSCTL_OFF))[u] = 0u;
    __syncthreads();
    XcdBarrier bar; bar.bar = (unsigned*)(F.ctl + CW_BAR); bar.x = 0; bar.st = nullptr;
    if (N_LAUNCHES == 1) bar = xcd_barrier_post((unsigned*)(F.ctl + CW_BAR), F.MISC + 8);
#define GRID_BAR() do { if (N_LAUNCHES == 1) { xcd_barrier(bar); } } while (0)
    const int lo = args.ph_lo, hi = args.ph_hi;
#define IN(k) (lo <= (k) && (k) < hi)
#define SEAM(k) do { if (IN(k) && IN((k) + 1)) GRID_BAR(); } while (0)
    float* Y = F.out + O_Y;
    if (IN(0)) { p0_prologue(F); VM_WAIT(); __syncthreads(); } SEAM(0);
    if (IN(1)) {
        { pg8::Gemm g{F.XN, F.Win_t, M, NPROJ, DM}; pg8::StaticOrder S; S.init(M, NPROJ, F.G, (int)blockIdx.x); pg8::EpiBf16P E{F.PROJ, NPROJ};
          pg8::gemm_phase<pg8::EpiBf16P, pg8::StaticOrder, true, true>(F.lds + RING_OFF, g, S, E); }
        { pg8::Gemm g{F.MN, F.Wckv_t, NBATCH * NMEM, 1024, DM}; pg8::StaticOrder S; const int nt1 = (M / 256) * (NPROJ / 256);
          S.init(NBATCH * NMEM, 1024, F.G, (int)((blockIdx.x + F.G - (nt1 % F.G)) % F.G)); pg8::EpiMemKV E{F.out + O_PMEMK, F.out + O_PMEMV, F.MKVB};
          pg8::gemm_phase<pg8::EpiMemKV, pg8::StaticOrder, true, true>(F.lds + RING_OFF, g, S, E); }
    } SEAM(1);
    if (IN(2)) { n1_conv(F); } SEAM(2);
    if (IN(3)) { n2_ssd(F); } SEAM(3);
    if (IN(4)) { n3_gate(F); n4_swa(F); } SEAM(4);
    if (IN(5)) { pg8::Gemm g{F.MIX, F.Wout_t, M, DM, DM}; pg8::StaticOrder S; S.init(M, DM, F.G, (int)blockIdx.x);
        pg8::EpiResid E{F.in[I_XP], F.in[I_XS], MP, Y, F.HB, F.SSQ1};
        pg8::gemm_phase<pg8::EpiResid, pg8::StaticOrder, true, true>(F.lds + RING_OFF, g, S, E); } SEAM(5);
    if (IN(6)) { pg8::Gemm g{F.HB, F.Wcq_t, M, CA, DM}; pg8::StaticOrder S; S.init(M, CA, F.G, (int)blockIdx.x);
        pg8::EpiScaleBf16 E{F.QC, CA, F.SSQ1, 0.08838834764831845f};
        pg8::gemm_phase<pg8::EpiScaleBf16, pg8::StaticOrder, true, true>(F.lds + RING_OFF, g, S, E); } SEAM(6);
    if (IN(7)) { n5_cross(F); } SEAM(7);
    if (IN(8)) { pg8::Gemm g{F.OC, F.Wco_t, M, DM, CA}; pg8::StaticOrder S; S.init(M, DM, F.G, (int)blockIdx.x);
        pg8::EpiResid E{Y, Y + (size_t)MP * DM, MP, Y, F.HB, F.SSQ2};
        pg8::gemm_phase<pg8::EpiResid, pg8::StaticOrder, true, true>(F.lds + RING_OFF, g, S, E); } SEAM(8);
    if (IN(9)) { pg8::Gemm g{F.HB, F.Wgu_t, M, 2 * DFF, DM}; pg8::StaticOrder S; S.init(M, 2 * DFF, F.G, (int)blockIdx.x);
        pg8::EpiSwiGLU E{F.HM, DFF, F.SSQ2};
        pg8::gemm_phase<pg8::EpiSwiGLU, pg8::StaticOrder, true, true>(F.lds + RING_OFF, g, S, E); } SEAM(9);
    if (IN(10)) { pg8::Gemm g{F.HM, F.Wd_t, M, DM, DFF}; pg8::StaticOrder S; S.init(M, DM, F.G, (int)blockIdx.x);
        pg8::EpiResid E{Y, Y + (size_t)MP * DM, MP, Y, nullptr, F.SSQ3};
        pg8::gemm_phase<pg8::EpiResid, pg8::StaticOrder, true, true>(F.lds + RING_OFF, g, S, E); } SEAM(10);
    if (IN(11)) { p11_final(F); }
#undef IN
#undef SEAM
}

extern "C" void kernel_launch(void* const* d_in, const int* in_sizes, int n_in, void* d_out, int out_size, void* d_ws, size_t ws_size, hipStream_t stream) {
    static int grid = 0;
    if (grid == 0) {
        if (n_in != 31 || out_size != (int)O_END || ws_size < WS_END) { fprintf(stderr, "kernel_launch: unexpected shapes: n_in %d out %d ws %zu\n", n_in, out_size, ws_size); grid = -1; return; }
        int dev = 0, cus = 0;
        if (hipGetDevice(&dev) != hipSuccess || hipDeviceGetAttribute(&cus, hipDeviceAttributeMultiprocessorCount, dev) != hipSuccess) { grid = -1; return; }
        if (hipFuncSetAttribute((const void*)skel_fwd, hipFuncAttributeMaxDynamicSharedMemorySize, LDS_BYTES) != hipSuccess) { fprintf(stderr, "kernel_launch: hipFuncSetAttribute failed\n"); grid = -1; return; }
        (void)hipGetLastError();
        grid = cus;
    }
    if (grid < 0) return;
    if (hipMemsetAsync((char*)d_ws + WS_CTL, 0, CTL_ZERO_BYTES, stream) != hipSuccess) { fprintf(stderr, "kernel_launch: memset failed\n"); return; }
    Args a{};
    for (int i = 0; i < 31; ++i) a.in[i] = (const float*)d_in[i];
    a.out = (float*)d_out; a.ws = (unsigned char*)d_ws;
    for (int li = 0; li < N_LAUNCHES; ++li) {
        a.ph_lo = (N_LAUNCHES == 1) ? 0 : li; a.ph_hi = (N_LAUNCHES == 1) ? NPH : li + 1; a.li = li;
        hipLaunchKernelGGL(skel_fwd, dim3(grid), dim3(NWAVES * 64), LDS_BYTES, stream, a);
        const hipError_t le = hipPeekAtLastError();
        if (le != hipSuccess) { fprintf(stderr, "kernel_launch: launch %d failed: %s\n", li, hipGetErrorName(le)); break; }
    }
}
```

```cpp
#include <hip/hip_runtime.h>
#include <cstdio>
#include <cstdint>
#include <cmath>
namespace pg8 {
#define PG8_LAS __attribute__((address_space(3)))
typedef unsigned short bf16_t;
typedef short bf16x8 __attribute__((ext_vector_type(8)));
typedef float f32x4 __attribute__((ext_vector_type(4)));
typedef unsigned u32x4 __attribute__((ext_vector_type(4)));
constexpr int BM = 256, BK = 64, HALF = 128, HTB = HALF * BK * 2  , STAGE_BYTES = 8 * HTB, NXCD = 8, WGM = 8;

__host__ __device__ __forceinline__ int lds_byte(int r, int c) { const int st = (r >> 4) * 2 + (c >> 5), rr = r & 15, cc = c & 31, ob = rr * 64 + cc * 2; return st * 1024 + (ob ^ (((ob >> 9) & 1) << 5)); }
__host__ __device__ __forceinline__ void stage_rc(int b, int& R, int& C) { const int st = b / 1024, sb = b % 1024, swz = sb ^ (((sb >> 9) & 1) << 5); R = (st >> 1) * 16 + swz / 64; C = (st & 1) * 32 + (swz % 64) / 2; }
__host__ __device__ __forceinline__ int perm32(int rho) { const int n = rho >> 4, i = rho & 15; return 8 * (i >> 2) + 4 * n + (i & 3); }

struct Unit { int pm, pn; };
struct Gemm { const bf16_t* A; const bf16_t* Bt; int M, N, K; };

struct StaticOrder {
    int nM, nN, nwg, G, c;
    __host__ __device__ void init(int M, int N, int G_, int c_) { nM = M / BM; nN = N / BM; nwg = nM * nN; G = G_; c = c_; }
    __host__ __device__ bool next(int i, Unit& u) const {
        const long L = (long)i * G + c; if (L >= nwg) return false;
        int wgid = (int)L; { const int q = nwg / NXCD, r = nwg % NXCD, xcd = wgid % NXCD, off = wgid / NXCD; wgid = (xcd < r ? xcd * (q + 1) : r * (q + 1) + (xcd - r) * q) + off; }
        const int nig = WGM * nN, gid = wgid / nig, fm = gid * WGM, gsz = (nM - fm) < WGM ? (nM - fm) : WGM;
        u.pm = fm + ((wgid % nig) % gsz); u.pn = (wgid % nig) / gsz; return true;
    }
    __device__ __forceinline__ void a_ready(const Unit&) const {}
    __device__ __forceinline__ void done(const Unit&) const {}
};

__device__ __forceinline__ unsigned cvt_pk_bf16(float lo, float hi) { unsigned r; asm volatile("v_cvt_pk_bf16_f32 %0, %1, %2" : "=v"(r) : "v"(lo), "v"(hi)); return r; }
typedef unsigned u32x2 __attribute__((ext_vector_type(2)));
constexpr float RMS_EPS = 1e-6f;
__device__ __forceinline__ float row_rstd(const float* ssq, int row, int fq) {
    const f32x4 p = *(const f32x4*)(ssq + (size_t)row * 16 + 4 * fq);
    float s = (p[0] + p[1]) + (p[2] + p[3]);
    s += __shfl_xor(s, 16); s += __shfl_xor(s, 32);
    return __builtin_amdgcn_rsqf(s * (1.0f / 1024.0f) + RMS_EPS);
}
__device__ __forceinline__ float silu_f(float x) { return x * __builtin_amdgcn_rcpf(1.0f + __expf(-x)); }

struct EpiBf16P {
    static constexpr bool PERM = true, AFTER_DRAIN = false;
    bf16_t* O; int ldc;
    __device__ __forceinline__ void operator()(const f32x4 (&acc)[2][2][4][2], const Unit& u, int wr, int wc, int fr, int fq) const {
        const int row0 = u.pm * BM + wr * 64 + fr, col0 = u.pn * BM + wc * 32 + 8 * fq;
#pragma unroll
        for (int ai = 0; ai < 2; ++ai)
#pragma unroll
            for (int m = 0; m < 4; ++m) { bf16_t* rowp = O + (size_t)(row0 + ai * HALF + m * 16) * ldc + col0;
#pragma unroll
                for (int bj = 0; bj < 2; ++bj) { const f32x4 v0 = acc[ai][bj][m][0], v1 = acc[ai][bj][m][1];
                    u32x4 w; w.x = cvt_pk_bf16(v0[0], v0[1]); w.y = cvt_pk_bf16(v0[2], v0[3]); w.z = cvt_pk_bf16(v1[0], v1[1]); w.w = cvt_pk_bf16(v1[2], v1[3]);
                    *(u32x4*)(rowp + bj * HALF) = w; } }
    }
};
struct EpiScaleBf16 {
    static constexpr bool PERM = true, AFTER_DRAIN = false;
    bf16_t* O; int ldc; const float* ssq; float scale;
    __device__ __forceinline__ void operator()(const f32x4 (&acc)[2][2][4][2], const Unit& u, int wr, int wc, int fr, int fq) const {
        const int row0 = u.pm * BM + wr * 64 + fr, col0 = u.pn * BM + wc * 32 + 8 * fq;
#pragma unroll
        for (int ai = 0; ai < 2; ++ai)
#pragma unroll
            for (int m = 0; m < 4; ++m) { const int row = row0 + ai * HALF + m * 16; const float r = row_rstd(ssq, row, fq) * scale; bf16_t* rowp = O + (size_t)row * ldc + col0;
#pragma unroll
                for (int bj = 0; bj < 2; ++bj) { const f32x4 v0 = acc[ai][bj][m][0] * r, v1 = acc[ai][bj][m][1] * r;
                    u32x4 w; w.x = cvt_pk_bf16(v0[0], v0[1]); w.y = cvt_pk_bf16(v0[2], v0[3]); w.z = cvt_pk_bf16(v1[0], v1[1]); w.w = cvt_pk_bf16(v1[2], v1[3]);
                    *(u32x4*)(rowp + bj * HALF) = w; } }
    }
};
struct EpiSwiGLU {
    static constexpr bool PERM = true, AFTER_DRAIN = false;
    bf16_t* O; int ldc; const float* ssq;
    __device__ __forceinline__ void operator()(const f32x4 (&acc)[2][2][4][2], const Unit& u, int wr, int wc, int fr, int fq) const {
        const int row0 = u.pm * BM + wr * 64 + fr, col0 = u.pn * HALF + wc * 32 + 8 * fq;
#pragma unroll
        for (int ai = 0; ai < 2; ++ai)
#pragma unroll
            for (int m = 0; m < 4; ++m) { const int row = row0 + ai * HALF + m * 16; const float r = row_rstd(ssq, row, fq);
                float h[8];
#pragma unroll
                for (int n = 0; n < 2; ++n)
#pragma unroll
                    for (int e = 0; e < 4; ++e) { const float g = acc[ai][0][m][n][e] * r, up = acc[ai][1][m][n][e] * r; h[4 * n + e] = silu_f(g) * up; }
                u32x4 w; w.x = cvt_pk_bf16(h[0], h[1]); w.y = cvt_pk_bf16(h[2], h[3]); w.z = cvt_pk_bf16(h[4], h[5]); w.w = cvt_pk_bf16(h[6], h[7]);
                *(u32x4*)(O + (size_t)row * ldc + col0) = w; }
    }
};
template <bool BASE_BF16> struct EpiResidB {
    static constexpr bool PERM = true, AFTER_DRAIN = false;
    const void* base; bf16_t* ob; float* ssq;
    __device__ __forceinline__ void operator()(const f32x4 (&acc)[2][2][4][2], const Unit& u, int wr, int wc, int fr, int fq) const {
        const int row0 = u.pm * BM + wr * 64 + fr, col0 = u.pn * BM + wc * 32 + 8 * fq;
#pragma unroll
        for (int ai = 0; ai < 2; ++ai)
#pragma unroll
            for (int m = 0; m < 4; ++m) { const int row = row0 + ai * HALF + m * 16; float ss = 0.f;
#pragma unroll
                for (int bj = 0; bj < 2; ++bj) { const size_t off = (size_t)row * 1024 + col0 + bj * HALF; f32x4 b0, b1;
                    if (BASE_BF16) { const u32x4 w = *(const u32x4*)((const bf16_t*)base + off);
                        b0 = (f32x4){__uint_as_float(w.x << 16), __uint_as_float(w.x & 0xffff0000u), __uint_as_float(w.y << 16), __uint_as_float(w.y & 0xffff0000u)};
                        b1 = (f32x4){__uint_as_float(w.z << 16), __uint_as_float(w.z & 0xffff0000u), __uint_as_float(w.w << 16), __uint_as_float(w.w & 0xffff0000u)}; }
                    else { b0 = *(const f32x4*)((const float*)base + off); b1 = *(const f32x4*)((const float*)base + off + 4); }
                    const f32x4 v0 = b0 + acc[ai][bj][m][0], v1 = b1 + acc[ai][bj][m][1];
                    ss += (v0[0] * v0[0] + v0[1] * v0[1]) + (v0[2] * v0[2] + v0[3] * v0[3]) + (v1[0] * v1[0] + v1[1] * v1[1]) + (v1[2] * v1[2] + v1[3] * v1[3]);
                    u32x4 w; w.x = cvt_pk_bf16(v0[0], v0[1]); w.y = cvt_pk_bf16(v0[2], v0[3]); w.z = cvt_pk_bf16(v1[0], v1[1]); w.w = cvt_pk_bf16(v1[2], v1[3]);
                    *(u32x4*)(ob + off) = w; }
                ss += __shfl_xor(ss, 16); ss += __shfl_xor(ss, 32);
                if (fq == 0) ssq[(size_t)row * 16 + u.pn * 4 + wc] = ss; }
    }
};
struct EpiMemKV {
    static constexpr bool PERM = false, AFTER_DRAIN = false;
    float* outk; float* outv; bf16_t* ob;
    __device__ __forceinline__ void operator()(const f32x4 (&acc)[2][2][4][2], const Unit& u, int wr, int wc, int fr, int fq) const {
        const int row0 = u.pm * BM + wr * 64 + fr, col0 = u.pn * BM + wc * 32 + 4 * fq;
#pragma unroll
        for (int ai = 0; ai < 2; ++ai)
#pragma unroll
            for (int m = 0; m < 4; ++m) { const int row = row0 + ai * HALF + m * 16;
#pragma unroll
                for (int bj = 0; bj < 2; ++bj)
#pragma unroll
                    for (int n = 0; n < 2; ++n) { const int c = col0 + bj * HALF + n * 16; const f32x4 v = acc[ai][bj][m][n];
                        float* o = (c < 512) ? outk + (size_t)row * 512 + c : outv + (size_t)row * 512 + (c - 512);
                        *(f32x4*)o = v; u32x2 w; w.x = cvt_pk_bf16(v[0], v[1]); w.y = cvt_pk_bf16(v[2], v[3]); *(u32x2*)(ob + (size_t)row * 1024 + c) = w; } }
    }
};
template <class Epi, class Sched, bool ALIGN_EPI = false, bool SP2 = false>
__device__ __forceinline__ void gemm_phase(PG8_LAS unsigned char* lds, const Gemm g, const Sched& S, const Epi& E) {
    const int tid = threadIdx.x, wid = __builtin_amdgcn_readfirstlane(tid >> 6), lane = tid & 63, wr = wid >> 2, wc = wid & 3, fr = lane & 15, fq = lane >> 4;
    const int K = g.K, nt = K / BK;
    unsigned voffA[2], voffB[2];
#pragma unroll
    for (int i = 0; i < 2; ++i) { int R, C; stage_rc(tid * 16 + i * 8192, R, C); const int Rb = Epi::PERM ? ((R & ~31) + perm32(R & 31)) : R;
        voffA[i] = (unsigned)(R * K + C) * 2u; voffB[i] = (unsigned)(Rb * K + C) * 2u; }
    const size_t kstep = (size_t)(BK * 2);
    const size_t hstep = (size_t)HALF * K * 2;
    const size_t tstep = 2 * hstep;
    const unsigned ldsw = (unsigned)wid * 1024u;
    const int aoff = lds_byte(wr * 64 + fr, fq * 8), boff = lds_byte(wc * 32 + fr, fq * 8);
#define PG8_SA(b, h) (((b) * 2 + (h)) * HTB)
#define PG8_SB(b, h) ((4 + (b) * 2 + (h)) * HTB)
#define PG8_STAGE(bufoff, gbase, voff) do { _Pragma("unroll") for (int _i = 0; _i < 2; ++_i) \
        __builtin_amdgcn_global_load_lds((const unsigned*)((const char*)(gbase) + (voff)[_i]), (PG8_LAS unsigned*)(lds + (bufoff) + ldsw + _i * 8192), 16, 0, 0); } while (0)
#define PG8_LDA(dst, b, h) do { _Pragma("unroll") for (int m = 0; m < 4; ++m) _Pragma("unroll") for (int k = 0; k < 2; ++k) dst[m][k] = *(const PG8_LAS bf16x8*)(lds + PG8_SA(b, h) + aoff + m * 2048 + k * 1024); } while (0)
#define PG8_LDB(dst, b, h) do { _Pragma("unroll") for (int n = 0; n < 2; ++n) _Pragma("unroll") for (int k = 0; k < 2; ++k) dst[n][k] = *(const PG8_LAS bf16x8*)(lds + PG8_SB(b, h) + boff + n * 2048 + k * 1024); } while (0)
#define PG8_MMA(ai, bj, At, Bt) do { __builtin_amdgcn_s_setprio(1); _Pragma("unroll") for (int m = 0; m < 4; ++m) _Pragma("unroll") for (int n = 0; n < 2; ++n) _Pragma("unroll") for (int k = 0; k < 2; ++k) \
        acc[ai][bj][m][n] = __builtin_amdgcn_mfma_f32_16x16x32_bf16(Bt[n][k], At[m][k], acc[ai][bj][m][n], 0, 0, 0); __builtin_amdgcn_s_setprio(0); } while (0)
#define PG8_WAIT_V(n) asm volatile("s_waitcnt vmcnt(" #n ")" ::: "memory")
#define PG8_WAIT_L(n) asm volatile("s_waitcnt lgkmcnt(" #n ")" ::: "memory")
#define PG8_BAR __builtin_amdgcn_s_barrier()
#define PG8_SCHED __builtin_amdgcn_sched_barrier(0)
    Unit cur, nxt; int ui = 0;
    if (!S.next(0, cur)) return;
    f32x4 acc[2][2][4][2];
#pragma unroll
    for (int a = 0; a < 2; ++a)
#pragma unroll
        for (int b = 0; b < 2; ++b)
#pragma unroll
            for (int m = 0; m < 4; ++m)
#pragma unroll
                for (int n = 0; n < 2; ++n) acc[a][b][m][n] = (f32x4){0.f, 0.f, 0.f, 0.f};
    bf16x8 At[4][2], B0[2][2], B1[2][2];
    const char* cA = (const char*)g.A + (size_t)cur.pm * tstep; const char* cB = (const char*)g.Bt + (size_t)cur.pn * tstep;
    S.a_ready(cur);
    if constexpr (SP2) {
        PG8_STAGE(PG8_SB(0, 0), cB, voffB); PG8_STAGE(PG8_SB(0, 1), cB + hstep, voffB); PG8_STAGE(PG8_SA(0, 0), cA, voffA); PG8_STAGE(PG8_SA(0, 1), cA + hstep, voffA);
        if (wr == 1) PG8_BAR;
        PG8_WAIT_V(2); PG8_BAR;
        PG8_STAGE(PG8_SB(1, 0), cB + kstep, voffB); PG8_STAGE(PG8_SA(1, 0), cA + kstep, voffA); PG8_STAGE(PG8_SB(1, 1), cB + hstep + kstep, voffB);
        PG8_WAIT_V(6); PG8_BAR;
    } else {
        PG8_STAGE(PG8_SB(0, 0), cB, voffB); PG8_STAGE(PG8_SA(0, 0), cA, voffA); PG8_STAGE(PG8_SB(0, 1), cB + hstep, voffB); PG8_STAGE(PG8_SA(0, 1), cA + hstep, voffA);
        if (wr == 1) PG8_BAR;
        PG8_WAIT_V(4); PG8_BAR;
        PG8_STAGE(PG8_SB(1, 0), cB + kstep, voffB); PG8_STAGE(PG8_SA(1, 0), cA + kstep, voffA); PG8_STAGE(PG8_SB(1, 1), cB + hstep + kstep, voffB);
        PG8_WAIT_V(6); PG8_BAR;
    }
    for (;;) {
        const bool has_next = S.next(ui + 1, nxt);
        const char* nA = has_next ? (const char*)g.A + (size_t)nxt.pm * tstep : cA; const char* nB = has_next ? (const char*)g.Bt + (size_t)nxt.pn * tstep : cB;
        for (int t = 0; t < nt; t += 2) {
            const bool last = (t == nt - 2);
            const char* a1 = cA + (size_t)(t + 1) * kstep;
            const char* a2 = last ? nA : cA + (size_t)(t + 2) * kstep; const char* b2 = last ? nB : cB + (size_t)(t + 2) * kstep;
            const char* a3 = a2 + kstep; const char* b3 = b2 + kstep;
            if (last && has_next) S.a_ready(nxt);
            if constexpr (SP2) {
            PG8_LDB(B0, 0, 0); PG8_LDB(B1, 0, 1); PG8_SCHED; PG8_LDA(At, 0, 0); PG8_STAGE(PG8_SA(1, 1), a1 + hstep, voffA);
            PG8_WAIT_V(8); PG8_WAIT_L(0); PG8_BAR; PG8_MMA(0, 0, At, B0); PG8_MMA(0, 1, At, B1); PG8_BAR; PG8_SCHED;
            PG8_LDA(At, 0, 1); PG8_STAGE(PG8_SB(0, 0), b2, voffB); PG8_STAGE(PG8_SB(0, 1), b2 + hstep, voffB); PG8_STAGE(PG8_SA(0, 0), a2, voffA);
            PG8_WAIT_V(8); PG8_WAIT_L(0); PG8_BAR; PG8_MMA(1, 0, At, B0); PG8_MMA(1, 1, At, B1); PG8_BAR; PG8_SCHED;
            PG8_LDB(B0, 1, 0); PG8_LDB(B1, 1, 1); PG8_SCHED; PG8_LDA(At, 1, 0); PG8_STAGE(PG8_SA(0, 1), a2 + hstep, voffA);
            PG8_WAIT_V(8); PG8_WAIT_L(0); PG8_BAR; PG8_MMA(0, 0, At, B0); PG8_MMA(0, 1, At, B1); PG8_BAR; PG8_SCHED;
            PG8_LDA(At, 1, 1); PG8_STAGE(PG8_SB(1, 0), b3, voffB); PG8_STAGE(PG8_SB(1, 1), b3 + hstep, voffB); PG8_STAGE(PG8_SA(1, 0), a3, voffA);
            PG8_WAIT_V(8); PG8_WAIT_L(0); PG8_BAR; PG8_MMA(1, 0, At, B0); PG8_MMA(1, 1, At, B1); PG8_BAR; PG8_SCHED;
            } else {
            PG8_LDB(B0, 0, 0); PG8_SCHED; PG8_LDA(At, 0, 0); PG8_STAGE(PG8_SA(1, 1), a1 + hstep, voffA);
            PG8_WAIT_L(8); PG8_BAR; PG8_WAIT_L(0); PG8_MMA(0, 0, At, B0); PG8_BAR; PG8_SCHED;
            PG8_LDB(B1, 0, 1); PG8_STAGE(PG8_SB(0, 0), b2, voffB);
            PG8_BAR; PG8_WAIT_L(0); PG8_MMA(0, 1, At, B1); PG8_BAR;
            PG8_LDA(At, 0, 1); PG8_STAGE(PG8_SA(0, 0), a2, voffA);
            PG8_BAR; PG8_WAIT_L(0); PG8_MMA(1, 0, At, B0); PG8_BAR; PG8_SCHED;
            PG8_STAGE(PG8_SB(0, 1), b2 + hstep, voffB);
            PG8_WAIT_V(6); PG8_BAR; PG8_MMA(1, 1, At, B1); PG8_BAR;
            PG8_LDB(B0, 1, 0); PG8_SCHED; PG8_LDA(At, 1, 0); PG8_STAGE(PG8_SA(0, 1), a2 + hstep, voffA);
            PG8_WAIT_L(8); PG8_BAR; PG8_WAIT_L(0); PG8_MMA(0, 0, At, B0); PG8_BAR; PG8_SCHED;
            PG8_LDB(B1, 1, 1); PG8_STAGE(PG8_SB(1, 0), b3, voffB);
            PG8_BAR; PG8_WAIT_L(0); PG8_MMA(0, 1, At, B1); PG8_BAR;
            PG8_LDA(At, 1, 1); PG8_STAGE(PG8_SA(1, 0), a3, voffA);
            PG8_BAR; PG8_WAIT_L(0); PG8_MMA(1, 0, At, B0); PG8_BAR; PG8_SCHED;
            PG8_STAGE(PG8_SB(1, 1), b3 + hstep, voffB);
            PG8_WAIT_V(6); PG8_BAR; PG8_MMA(1, 1, At, B1); PG8_BAR;
            }
        }
        if constexpr (ALIGN_EPI) { if (wr == 0) PG8_BAR; }
        if constexpr (!Epi::AFTER_DRAIN) { E(acc, cur, wr, wc, fr, fq); S.done(cur); }
        if (!has_next) break;
#pragma unroll
        for (int a = 0; a < 2; ++a)
#pragma unroll
            for (int b = 0; b < 2; ++b)
#pragma unroll
                for (int m = 0; m < 4; ++m)
#pragma unroll
                    for (int n = 0; n < 2; ++n) acc[a][b][m][n] = (f32x4){0.f, 0.f, 0.f, 0.f};
        cur = nxt; cA = nA; cB = nB; ++ui;
        if constexpr (ALIGN_EPI) { if (wr == 1) PG8_BAR; }
    }
    PG8_WAIT_V(0);
    if constexpr (!ALIGN_EPI) { if (wr == 0) PG8_BAR; }
    PG8_BAR;
    if constexpr (Epi::AFTER_DRAIN) { E.fused(acc, cur, wr, wc, fr, fq, lds, wid, lane); S.done(cur); }
#undef PG8_SA
#undef PG8_SB
#undef PG8_STAGE
#undef PG8_LDA
#undef PG8_LDB
#undef PG8_MMA
#undef PG8_WAIT_V
#undef PG8_WAIT_L
#undef PG8_BAR
#undef PG8_SCHED
}
}
#define GAS __attribute__((address_space(1)))
#define LAS __attribute__((address_space(3)))
typedef unsigned short bf16;
typedef unsigned v4u __attribute__((ext_vector_type(4)));
typedef float f32x4 __attribute__((ext_vector_type(4)));
typedef short bf16x8 __attribute__((ext_vector_type(8)));
typedef GAS unsigned gu32;
typedef GAS unsigned long long gu64;
#define RLX_AGENT __ATOMIC_RELAXED, __HIP_MEMORY_SCOPE_AGENT
#define LDS_WAIT() asm volatile("s_waitcnt lgkmcnt(0)" ::: "memory")
#define VM_WAIT() asm volatile("s_waitcnt vmcnt(0)" ::: "memory")
__device__ __forceinline__ unsigned long long rt() { return __builtin_amdgcn_s_memrealtime(); }
__device__ __forceinline__ unsigned f2bf(float f) { unsigned u = __builtin_bit_cast(unsigned, f); return (u + 0x7fffu + ((u >> 16) & 1u)) >> 16; }
__device__ __forceinline__ unsigned pk2(float lo, float hi) { return f2bf(lo) | (f2bf(hi) << 16); }

#define XB_TMO      128
#define XB_XCNT(j)  (256  + 64 * (j))
#define XB_XSUB(j)  (1280 + 64 * (j))
#define XB_XGEN(j)  (2304 + 64 * (j))
#define XB_TOP      3328
#define XB_TOPGEN   3392
#define XCD_BAR_WORDS 3456
#define XB_SPIN_CAP (1u << 18)

__device__ __forceinline__ unsigned xb_ld(unsigned* p)              { return __hip_atomic_load(p, __ATOMIC_RELAXED, __HIP_MEMORY_SCOPE_AGENT); }
__device__ __forceinline__ unsigned xb_add(unsigned* p, unsigned v) { return __hip_atomic_fetch_add(p, v, __ATOMIC_RELAXED, __HIP_MEMORY_SCOPE_AGENT); }
__device__ __forceinline__ unsigned xb_xcc_id() { return (unsigned)__builtin_amdgcn_s_getreg((3 << 11) | 20) & 0xFu; }
#define XB_SPIN(cond, bar) do { unsigned _sp = 0; while (cond) { __builtin_amdgcn_s_sleep(1); \
    if ((++_sp & 255u) == 0u) { if (xb_ld(&(bar)[XB_TMO])) break; if (_sp > XB_SPIN_CAP) { atomicAdd(&(bar)[XB_TMO], 1u); break; } } } } while (0)

struct XcdBarrier {
    unsigned* bar; unsigned x;
    volatile LAS unsigned* st;
};

__device__ __forceinline__ XcdBarrier xcd_barrier_post(unsigned* bar, volatile LAS unsigned* st) {
    XcdBarrier b; b.bar = bar; b.x = xb_xcc_id(); b.st = st;
    if (threadIdx.x == 0) (void)xb_add(&bar[XB_XCNT(b.x)], 1u);
    return b;
}
__device__ __forceinline__ void xcd_barrier_complete(unsigned* bar, unsigned x, unsigned& nloc, unsigned& nx) {
    const unsigned G = gridDim.x * gridDim.y * gridDim.z;
    unsigned sum, cnt, mine, sp = 0u;
    for (;;) {
        sum = 0u; cnt = 0u; mine = 0u;
#pragma unroll
        for (unsigned j = 0; j < 16; ++j) { const unsigned c = xb_ld(&bar[XB_XCNT(j)]); sum += c; cnt += (c > 0u) ? 1u : 0u; mine = (j == x) ? c : mine; }
        if (sum == G) break;
        __builtin_amdgcn_s_sleep(1);
        if ((++sp & 255u) == 0u) { if (xb_ld(&bar[XB_TMO])) break; if (sp > XB_SPIN_CAP) { atomicAdd(&bar[XB_TMO], 1u); break; } }
    }
    nloc = mine > 0u ? mine : 1u; nx = cnt > 0u ? cnt : 1u;
}

__device__ __forceinline__ void xcd_barrier(const XcdBarrier& b) {
    asm volatile("s_waitcnt vmcnt(0)" ::: "memory");
    __syncthreads();
    if (threadIdx.x == 0) {
        unsigned* bar = b.bar;
        __builtin_amdgcn_s_waitcnt(0);
        unsigned nloc = b.st[0], nx = b.st[1];
        if (nloc == 0u) { xcd_barrier_complete(bar, b.x, nloc, nx); b.st[0] = nloc; b.st[1] = nx; }
        const unsigned old = xb_add(&bar[XB_XSUB(b.x)], 1u);
        const unsigned gen = old / nloc;
        if (old + 1u == (gen + 1u) * nloc) {
            __builtin_amdgcn_fence(__ATOMIC_RELEASE, "agent");
            asm volatile("s_waitcnt vmcnt(0)" ::: "memory");
            const unsigned og = xb_add(&bar[XB_TOP], 1u);
            const unsigned tg = og / nx;
            if (og + 1u == (tg + 1u) * nx) xb_add(&bar[XB_TOPGEN], 1u);
            else XB_SPIN(xb_ld(&bar[XB_TOPGEN]) == tg, bar);
            __builtin_amdgcn_fence(__ATOMIC_ACQUIRE, "agent");
            xb_add(&bar[XB_XGEN(b.x)], 1u);
            asm volatile("s_waitcnt vmcnt(0)" ::: "memory");
        } else {
            XB_SPIN(xb_ld(&bar[XB_XGEN(b.x)]) == gen, bar);
            __builtin_amdgcn_fence(__ATOMIC_ACQUIRE, "agent");
            asm volatile("s_waitcnt vmcnt(0)" ::: "memory");
        }
    }
    __syncthreads();
}
constexpr int DM = 1024, NBATCH = 8, SEQ = 4096, MP = NBATCH * SEQ, NSS = 128, TS = 8, MS = NSS * TS, M = MP + MS;
constexpr int NPROJ = 2304, IN_DIM = 2312, DFF = 2816, NMEM = 256, CA = 512;
constexpr int PZ = 0, PXBC = 512, PQ = 1536, PK = 2048, PV = 2176;
constexpr float EPS = 1e-6f;
constexpr int NWAVES = 8;
constexpr size_t O_Y = 0, O_PCONV = 34603008, O_PSSM = 34627584, O_PSWAK = 35151872, O_PSWAV = 35282944, O_PMEMK = 35414016, O_PMEMV = 36462592,
                 O_SCONV = 37511168, O_SSSM = 37904384, O_SSWAK = 46292992, O_SSWAV = 48390144, O_END = 50487296;
constexpr size_t MiB = 1u << 20;
constexpr size_t WS_CTL = 0, CTL_ZERO_BYTES = 1 * MiB;
constexpr size_t WS_WIN = 2 * MiB, WS_WOUT = 7 * MiB, WS_WCQ = 9 * MiB, WS_WCKV = 10 * MiB, WS_WCO = 12 * MiB, WS_WGU = 13 * MiB, WS_WD = 24 * MiB;
constexpr size_t WS_DT = 30 * MiB, WS_SSQ1 = 32 * MiB, WS_SSQ2 = 35 * MiB, WS_SSQ3 = 38 * MiB, WS_MN = 41 * MiB, WS_MKVB = 45 * MiB;
constexpr size_t WS_R1 = 50 * MiB;
constexpr size_t WS_R2 = 116 * MiB;
constexpr size_t WS_R3 = 298 * MiB;
constexpr size_t WS_HS = 364 * MiB;
constexpr size_t WS_XCS = 396 * MiB, WS_YSS = 398 * MiB, WS_CD = 400 * MiB;
constexpr size_t WS_HB = 430 * MiB;
constexpr size_t WS_END = 496 * MiB;
constexpr int CW_BAR = 4096;
constexpr int RING_OFF = 0, RING_BYTES = 154624, LDSCTL_OFF = RING_BYTES, MISC_OFF = LDSCTL_OFF + 320, LDS_BYTES = 155648;

__device__ __forceinline__ float bf2f(unsigned short b) { return __uint_as_float((unsigned)b << 16); }
__device__ __forceinline__ float bflo(unsigned w) { return __uint_as_float(w << 16); }
__device__ __forceinline__ float bfhi(unsigned w) { return __uint_as_float(w & 0xffff0000u); }
__device__ __forceinline__ float wave_sum(float v) {
#pragma unroll
    for (int o = 1; o < 64; o <<= 1) v += __shfl_xor(v, o);
    return v;
}
__device__ __forceinline__ float wave_max(float v) {
#pragma unroll
    for (int o = 1; o < 64; o <<= 1) v = fmaxf(v, __shfl_xor(v, o));
    return v;
}
__device__ __forceinline__ float silu(float x) { return x / (1.0f + __expf(-x)); }
__device__ __forceinline__ float softplus(float x) { return fmaxf(x, 0.f) + log1pf(__expf(-fabsf(x))); }
__device__ __forceinline__ int t5_bucket(int n) { if (n < 16) return n; int l = 16 + (int)(logf((float)n * (1.0f / 16.0f)) / logf(8.0f) * 16.0f); return l < 31 ? l : 31; }

struct Frame {
    LAS unsigned char* lds;
    volatile LAS unsigned* MISC;
    gu32* ctl;
    int tid, lane, wave, vcu, G;
    const float* const __attribute__((address_space(4)))* in;
    float* out;
    bf16 *Win_t, *Wout_t, *Wcq_t, *Wckv_t, *Wco_t, *Wgu_t, *Wd_t;
    float *DT, *SSQ1, *SSQ2, *SSQ3, *YS, *ST, *CD;
    bf16 *MN, *MKVB, *XN, *MIX, *PROJ, *HM, *XC, *QC, *OC, *HB, *HS;
};
enum { I_XP = 0, I_XS, I_MEMP, I_SCONV, I_SSSM, I_CSWAK, I_CSWAV, I_CMEMK, I_CMEMV, I_RELB, I_GMIX, I_WIN, I_CONVW, I_CONVB, I_DTB, I_ALOG, I_DSKIP, I_GSSD, I_SINKS, I_WOUT,
       I_GCROSS, I_GMEM, I_WCQ, I_WCK, I_WCV, I_WCO, I_GFFN, I_WGATE, I_WUP, I_WDOWN, I_GFINAL };

__device__ __forceinline__ void p0_transpose_item(const float* W, int ldw, int src_col0, int K, bf16* WT, int dst_row0, const float* gk, LAS float* scr, int kb, int lane) {
    const int k0 = 64 * kb;
#pragma unroll 8
    for (int i = 0; i < 32; ++i) { const int kk = 2 * i + (lane >> 5); float v = W[(size_t)(k0 + kk) * ldw + src_col0 + (lane & 31)]; if (gk) v *= gk[k0 + kk]; scr[kk * 33 + (lane & 31)] = v; }
    LDS_WAIT(); asm volatile("" ::: "memory");
    const int c = lane & 7;
#pragma unroll
    for (int j = 0; j < 4; ++j) { const int n = (lane >> 3) + 8 * j; const LAS float* s = scr + (8 * c) * 33 + n;
        v4u o; o.x = pk2(s[0 * 33], s[1 * 33]); o.y = pk2(s[2 * 33], s[3 * 33]); o.z = pk2(s[4 * 33], s[5 * 33]); o.w = pk2(s[6 * 33], s[7 * 33]);
        *(GAS v4u*)(WT + (size_t)(dst_row0 + n) * K + k0 + 8 * c) = o; }
    LDS_WAIT(); asm volatile("" ::: "memory");
}
__device__ __forceinline__ void p0_norm_row(const float* xrow, const float* g, bf16* orow, float* dtout, const LAS float* wdtT, int lane) {
    const GAS f32x4* xr = (const GAS f32x4*)xrow + lane; const GAS f32x4* gr = (const GAS f32x4*)g + lane;
    f32x4 v[4]; float s = 0.f;
#pragma unroll
    for (int j = 0; j < 4; ++j) { v[j] = xr[64 * j]; s += (v[j].x * v[j].x + v[j].y * v[j].y) + (v[j].z * v[j].z + v[j].w * v[j].w); }
    const float rstd = 1.0f / sqrtf(wave_sum(s) * (1.f / DM) + EPS);
#pragma unroll
    for (int j = 0; j < 4; ++j) v[j] = v[j] * rstd * gr[64 * j];
    GAS unsigned long long* o8 = (GAS unsigned long long*)orow + lane;
#pragma unroll
    for (int j = 0; j < 4; ++j) o8[64 * j] = (unsigned long long)pk2(v[j].x, v[j].y) | ((unsigned long long)pk2(v[j].z, v[j].w) << 32);
    if (dtout) {
        float a[8];
#pragma unroll
        for (int h = 0; h < 8; ++h) { float acc = 0.f;
#pragma unroll
            for (int j = 0; j < 4; ++j) { const f32x4 w = *(const LAS f32x4*)(wdtT + h * 1024 + 256 * j + 4 * lane); acc += (v[j].x * w.x + v[j].y * w.y) + (v[j].z * w.z + v[j].w * w.w); }
            a[h] = wave_sum(acc); }
        if (lane == 0) { *(f32x4*)(dtout) = (f32x4){a[0], a[1], a[2], a[3]}; *(f32x4*)(dtout + 4) = (f32x4){a[4], a[5], a[6], a[7]}; }
    }
}
__device__ __forceinline__ void p0_prologue(const Frame& F) {
    LAS float* wdtT = (LAS float*)(F.lds + RING_OFF);
    LAS float* scr = (LAS float*)(F.lds + RING_OFF + 32768 + F.wave * 12288);
    const float* w_in = F.in[I_WIN];
    for (int idx = F.tid; idx < 8192; idx += NWAVES * 64) { const int h = idx >> 10, k = idx & 1023; wdtT[idx] = w_in[(size_t)k * IN_DIM + 1536 + h]; }
    __syncthreads();
    const int gw = F.vcu * NWAVES + F.wave, NGW = F.G * NWAVES;
    constexpr int I1 = 72 * 16, I2 = 32 * 16, I3 = 16 * 16, I4 = 32 * 16, I5 = 32 * 8, I6 = 176 * 16, I7 = 32 * 44, NITEMS = I1 + I2 + I3 + I4 + I5 + I6 + I7;
    for (int it = gw; it < NITEMS; it += NGW) {
        int r = it;
        if (r < I1) { const int nb = r / 16, kb = r % 16, d0 = 32 * nb; p0_transpose_item(w_in, IN_DIM, d0 < 1536 ? d0 : d0 + 8, DM, F.Win_t, d0, nullptr, scr, kb, F.lane); continue; } r -= I1;
        if (r < I2) { const int nb = r / 16, kb = r % 16; p0_transpose_item(F.in[I_WOUT], DM, 32 * nb, DM, F.Wout_t, 32 * nb, nullptr, scr, kb, F.lane); continue; } r -= I2;
        if (r < I3) { const int nb = r / 16, kb = r % 16; p0_transpose_item(F.in[I_WCQ], CA, 32 * nb, DM, F.Wcq_t, 32 * nb, F.in[I_GCROSS], scr, kb, F.lane); continue; } r -= I3;
        if (r < I4) { const int nb = r / 16, kb = r % 16, d0 = 32 * nb; p0_transpose_item(d0 < 512 ? F.in[I_WCK] : F.in[I_WCV], CA, d0 & 511, DM, F.Wckv_t, d0, nullptr, scr, kb, F.lane); continue; } r -= I4;
        if (r < I5) { const int nb = r / 8, kb = r % 8; p0_transpose_item(F.in[I_WCO], DM, 32 * nb, CA, F.Wco_t, 32 * nb, nullptr, scr, kb, F.lane); continue; } r -= I5;
        if (r < I6) { const int nb = r / 16, kb = r % 16, d0 = 32 * nb, tile = d0 >> 8, within = d0 & 255;
            p0_transpose_item(within < 128 ? F.in[I_WGATE] : F.in[I_WUP], DFF, tile * 128 + (within & 127), DM, F.Wgu_t, d0, F.in[I_GFFN], scr, kb, F.lane); continue; } r -= I6;
        { const int nb = r / 44, kb = r % 44; p0_transpose_item(F.in[I_WDOWN], DM, 32 * nb, DFF, F.Wd_t, 32 * nb, nullptr, scr, kb, F.lane); }
    }
    for (int m = gw; m < M; m += NGW) {
        const float* xrow = m < MP ? F.in[I_XP] + (size_t)m * DM : F.in[I_XS] + (size_t)(m - MP) * DM;
        p0_norm_row(xrow, F.in[I_GMIX], F.XN + (size_t)m * DM, F.DT + (size_t)m * 8, wdtT, F.lane);
    }
    for (int m = gw; m < NBATCH * NMEM; m += NGW) p0_norm_row(F.in[I_MEMP] + (size_t)m * DM, F.in[I_GMEM], F.MN + (size_t)m * DM, nullptr, wdtT, F.lane);
}

__device__ __forceinline__ void n1_conv(const Frame& F) {
    const int gw = F.vcu * NWAVES + F.wave, NGW = F.G * NWAVES, lane = F.lane;
    const float* cw = F.in[I_CONVW]; const float* cb = F.in[I_CONVB];
    for (int m = MP + gw; m < M; m += NGW) {
        const bool samp = m >= MP; int t, L, seq;
        if (!samp) { seq = m / SEQ; t = m % SEQ; L = SEQ; } else { const int r = m - MP; seq = r / TS; t = r % TS; L = TS; }
        const float* hist = F.in[I_SCONV] + (size_t)seq * 3 * 1024;
#pragma unroll
        for (int j2 = 0; j2 < 2; ++j2) {
            const int c = 8 * lane + 512 * j2;
            float acc[8];
            { const f32x4 b0 = *(const f32x4*)(cb + c), b1 = *(const f32x4*)(cb + c + 4); acc[0] = b0.x; acc[1] = b0.y; acc[2] = b0.z; acc[3] = b0.w; acc[4] = b1.x; acc[5] = b1.y; acc[6] = b1.z; acc[7] = b1.w; }
            v4u raw_last = (v4u){0u, 0u, 0u, 0u};
#pragma unroll
            for (int k = 0; k < 4; ++k) {
                const int tt = t - 3 + k; float xv[8];
                if (tt >= 0) { const v4u raw = *(const v4u*)(F.PROJ + (size_t)(m - 3 + k) * NPROJ + PXBC + c);
                    xv[0] = bflo(raw.x); xv[1] = bfhi(raw.x); xv[2] = bflo(raw.y); xv[3] = bfhi(raw.y); xv[4] = bflo(raw.z); xv[5] = bfhi(raw.z); xv[6] = bflo(raw.w); xv[7] = bfhi(raw.w);
                    if (k == 3) raw_last = raw; }
                else if (samp) { const f32x4 h0 = *(const f32x4*)(hist + (size_t)(tt + 3) * 1024 + c), h1 = *(const f32x4*)(hist + (size_t)(tt + 3) * 1024 + c + 4);
                    xv[0] = h0.x; xv[1] = h0.y; xv[2] = h0.z; xv[3] = h0.w; xv[4] = h1.x; xv[5] = h1.y; xv[6] = h1.z; xv[7] = h1.w; }
                else {
#pragma unroll
                    for (int e = 0; e < 8; ++e) xv[e] = 0.f; }
                const f32x4 w0 = *(const f32x4*)(cw + k * 1024 + c), w1 = *(const f32x4*)(cw + k * 1024 + c + 4);
                acc[0] += xv[0] * w0.x; acc[1] += xv[1] * w0.y; acc[2] += xv[2] * w0.z; acc[3] += xv[3] * w0.w; acc[4] += xv[4] * w1.x; acc[5] += xv[5] * w1.y; acc[6] += xv[6] * w1.z; acc[7] += xv[7] * w1.w;
            }
#pragma unroll
            for (int e = 0; e < 8; ++e) acc[e] = silu(acc[e]);
            v4u o; o.x = pk2(acc[0], acc[1]); o.y = pk2(acc[2], acc[3]); o.z = pk2(acc[4], acc[5]); o.w = pk2(acc[6], acc[7]);
            *(v4u*)(F.XC + (size_t)m * 1024 + c) = o;
            if (t >= L - 3) {
                const int j = t - (L - 3);
                float* dst = F.out + (samp ? O_SCONV : O_PCONV) + ((size_t)seq * 3 + j) * 1024 + c;
                *(f32x4*)dst = (f32x4){bflo(raw_last.x), bfhi(raw_last.x), bflo(raw_last.y), bfhi(raw_last.y)};
                *(f32x4*)(dst + 4) = (f32x4){bflo(raw_last.z), bfhi(raw_last.z), bflo(raw_last.w), bfhi(raw_last.w)};
            }
        }
    }
    for (int it = gw; it < NBATCH * 3; it += NGW) {
        const int b = it / 3, j = it % 3; const bf16* src = F.PROJ + (size_t)(b * SEQ + SEQ - 3 + j) * NPROJ + PXBC; float* dst = F.out + O_PCONV + (size_t)it * 1024;
        for (int c = lane; c < 1024; c += 64) dst[c] = bf2f(src[c]);
    }
    for (int it = gw; it < NBATCH * 128 + NSS * 128; it += NGW) {
        const int c = 2 * lane;
        if (it < NBATCH * 128) { const int b = it >> 7, j = it & 127; const size_t src = (size_t)(b * SEQ + SEQ - 128 + j) * NPROJ;
            const unsigned kw = *(const unsigned*)(F.PROJ + src + PK + c), vw = *(const unsigned*)(F.PROJ + src + PV + c);
            float* ok = F.out + O_PSWAK + (size_t)it * 128 + c; float* ov = F.out + O_PSWAV + (size_t)it * 128 + c;
            ok[0] = bflo(kw); ok[1] = bfhi(kw); ov[0] = bflo(vw); ov[1] = bfhi(vw); }
        else { const int r = it - NBATCH * 128, s = r >> 7, j = r & 127; float* ok = F.out + O_SSWAK + (size_t)r * 128 + c; float* ov = F.out + O_SSWAV + (size_t)r * 128 + c;
            if (j < 120) { const size_t src = ((size_t)s * 128 + j + 8) * 128 + c; ok[0] = F.in[I_CSWAK][src]; ok[1] = F.in[I_CSWAK][src + 1]; ov[0] = F.in[I_CSWAV][src]; ov[1] = F.in[I_CSWAV][src + 1]; }
            else { const size_t src = (size_t)(MP + s * TS + j - 120) * NPROJ; const unsigned kw = *(const unsigned*)(F.PROJ + src + PK + c), vw = *(const unsigned*)(F.PROJ + src + PV + c);
                ok[0] = bflo(kw); ok[1] = bfhi(kw); ov[0] = bflo(vw); ov[1] = bfhi(vw); } }
    }
}

struct SsdStep { v4u b0, b1, c0, c1; float dtr; unsigned short xr; };
__device__ __forceinline__ void n2_load(SsdStep& s, const bf16* XC, const float* DT, size_t m, int h, int p, int g, int nq) {
    const bf16* row = XC + m * 1024;
    s.b0 = *(const v4u*)(row + 512 + g * 128 + nq * 16); s.b1 = *(const v4u*)(row + 512 + g * 128 + nq * 16 + 8);
    s.c0 = *(const v4u*)(row + 768 + g * 128 + nq * 16); s.c1 = *(const v4u*)(row + 768 + g * 128 + nq * 16 + 8);
    s.dtr = DT[m * 8 + h]; s.xr = row[h * 64 + p];
}
__device__ __forceinline__ void n2_step(const SsdStep& s, float (&st)[16], float A, float dtb, float dsk, float* YS, size_t m, int h, int p, int nq) {
    const float xv = bf2f(s.xr), dt = softplus(s.dtr + dtb), dA = __expf(dt * A), dx = dt * xv;
    const unsigned bw[8] = {s.b0.x, s.b0.y, s.b0.z, s.b0.w, s.b1.x, s.b1.y, s.b1.z, s.b1.w};
    const unsigned cw[8] = {s.c0.x, s.c0.y, s.c0.z, s.c0.w, s.c1.x, s.c1.y, s.c1.z, s.c1.w};
    float y = 0.f;
#pragma unroll
    for (int i = 0; i < 8; ++i) {
        st[2 * i] = dA * st[2 * i] + dx * bflo(bw[i]); st[2 * i + 1] = dA * st[2 * i + 1] + dx * bfhi(bw[i]);
        y += st[2 * i] * bflo(cw[i]) + st[2 * i + 1] * bfhi(cw[i]);
    }
    y += __shfl_xor(y, 1); y += __shfl_xor(y, 2); y += __shfl_xor(y, 4);
    if (nq == 0) YS[m * 512 + h * 64 + p] = y + dsk * xv;
}
__device__ __forceinline__ void n2_ssd(const Frame& F) {
    const int gw = F.vcu * NWAVES + F.wave, NGW = F.G * NWAVES, lane = F.lane;
    const int NIT = (NBATCH + NSS) * 64;
    for (int it = NBATCH * 64 + gw; it < NIT; it += NGW) {
        const int seq = it >> 6, h = (it >> 3) & 7, pg = it & 7, pl = lane >> 3, nq = lane & 7, p = pg * 8 + pl, g = h >> 2;
        const bool samp = seq >= NBATCH; const int T = samp ? TS : SEQ; const size_t m0 = samp ? (size_t)MP + (size_t)(seq - NBATCH) * TS : (size_t)seq * SEQ;
        float st[16];
        if (samp) { const float* s0 = F.in[I_SSSM] + (((size_t)(seq - NBATCH) * 8 + h) * 64 + p) * 128 + nq * 16;
#pragma unroll
            for (int i = 0; i < 4; ++i) { const f32x4 v = *(const f32x4*)(s0 + 4 * i); st[4 * i] = v.x; st[4 * i + 1] = v.y; st[4 * i + 2] = v.z; st[4 * i + 3] = v.w; } }
        else {
#pragma unroll
            for (int i = 0; i < 16; ++i) st[i] = 0.f; }
        const float A = -__expf(F.in[I_ALOG][h]), dtb = F.in[I_DTB][h], dsk = F.in[I_DSKIP][h];
        SsdStep c0, c1, c2, c3, n0, n1, n2, n3;
        n2_load(c0, F.XC, F.DT, m0 + 0, h, p, g, nq); n2_load(c1, F.XC, F.DT, m0 + 1, h, p, g, nq); n2_load(c2, F.XC, F.DT, m0 + 2, h, p, g, nq); n2_load(c3, F.XC, F.DT, m0 + 3, h, p, g, nq);
        for (int t = 0; t < T; t += 4) {
            const size_t m = m0 + t; const size_t mn = (t + 4 < T) ? m + 4 : m;
            n2_load(n0, F.XC, F.DT, mn + 0, h, p, g, nq); n2_load(n1, F.XC, F.DT, mn + 1, h, p, g, nq); n2_load(n2, F.XC, F.DT, mn + 2, h, p, g, nq); n2_load(n3, F.XC, F.DT, mn + 3, h, p, g, nq);
            n2_step(c0, st, A, dtb, dsk, F.YS, m + 0, h, p, nq); n2_step(c1, st, A, dtb, dsk, F.YS, m + 1, h, p, nq);
            n2_step(c2, st, A, dtb, dsk, F.YS, m + 2, h, p, nq); n2_step(c3, st, A, dtb, dsk, F.YS, m + 3, h, p, nq);
            c0 = n0; c1 = n1; c2 = n2; c3 = n3;
        }
        float* so = F.out + (samp ? O_SSSM + (((size_t)(seq - NBATCH) * 8 + h) * 64 + p) * 128 : O_PSSM + (((size_t)seq * 8 + h) * 64 + p) * 128) + nq * 16;
#pragma unroll
        for (int i = 0; i < 4; ++i) *(f32x4*)(so + 4 * i) = (f32x4){st[4 * i], st[4 * i + 1], st[4 * i + 2], st[4 * i + 3]};
    }
}

__device__ __forceinline__ void n3_gate(const Frame& F) {
    const int gw = F.vcu * NWAVES + F.wave, NGW = F.G * NWAVES, lane = F.lane, c = 8 * lane;
    const float* gn = F.in[I_GSSD];
    for (int m = MP + gw; m < M; m += NGW) {
        const f32x4 y0 = *(const f32x4*)(F.YS + (size_t)m * 512 + c), y1 = *(const f32x4*)(F.YS + (size_t)m * 512 + c + 4);
        const v4u zr = *(const v4u*)(F.PROJ + (size_t)m * NPROJ + PZ + c);
        float v[8] = {y0.x, y0.y, y0.z, y0.w, y1.x, y1.y, y1.z, y1.w};
        const float z[8] = {bflo(zr.x), bfhi(zr.x), bflo(zr.y), bfhi(zr.y), bflo(zr.z), bfhi(zr.z), bflo(zr.w), bfhi(zr.w)};
        float ss = 0.f;
#pragma unroll
        for (int e = 0; e < 8; ++e) { v[e] = v[e] * silu(z[e]); ss += v[e] * v[e]; }
#pragma unroll
        for (int o = 1; o < 32; o <<= 1) ss += __shfl_xor(ss, o);
        const float rs = 1.0f / sqrtf(ss * (1.0f / 256.0f) + EPS);
        const f32x4 g0 = *(const f32x4*)(gn + c), g1 = *(const f32x4*)(gn + c + 4);
        v4u o; o.x = pk2(v[0] * rs * g0.x, v[1] * rs * g0.y); o.y = pk2(v[2] * rs * g0.z, v[3] * rs * g0.w); o.z = pk2(v[4] * rs * g1.x, v[5] * rs * g1.y); o.w = pk2(v[6] * rs * g1.z, v[7] * rs * g1.w);
        *(v4u*)(F.MIX + (size_t)m * 1024 + c) = o;
    }
}

__device__ __forceinline__ void n4_swa(const Frame& F) {
    const int gw = F.vcu * NWAVES + F.wave, NGW = F.G * NWAVES, lane = F.lane;
    const float* relb = F.in[I_RELB]; const float* sinks = F.in[I_SINKS];
    for (int it = gw; it < M * 8; it += NGW) {
        const int m = it >> 3, head = it & 7, kv = head >> 2;
        const bool samp = m >= MP; int t, seq;
        if (!samp) { seq = m / SEQ; t = m % SEQ; } else { const int r = m - MP; seq = r / TS; t = r % TS; }
        v4u q[8];
#pragma unroll
        for (int i = 0; i < 8; ++i) q[i] = *(const v4u*)(F.PROJ + (size_t)m * NPROJ + PQ + head * 64 + 8 * i);
        float sc[2];
#pragma unroll
        for (int hh = 0; hh < 2; ++hh) {
            const int dist = lane + 64 * hh, tk = t - dist; float dot = 0.f; bool valid = true;
            if (tk >= 0) { const bf16* kr = F.PROJ + (size_t)(m - dist) * NPROJ + PK + kv * 64;
#pragma unroll
                for (int i = 0; i < 8; ++i) { const v4u k8 = *(const v4u*)(kr + 8 * i);
                    dot += bflo(q[i].x) * bflo(k8.x) + bfhi(q[i].x) * bfhi(k8.x) + bflo(q[i].y) * bflo(k8.y) + bfhi(q[i].y) * bfhi(k8.y)
                         + bflo(q[i].z) * bflo(k8.z) + bfhi(q[i].z) * bfhi(k8.z) + bflo(q[i].w) * bflo(k8.w) + bfhi(q[i].w) * bfhi(k8.w); } }
            else if (samp) { const float* kr = F.in[I_CSWAK] + (((size_t)seq * 128 + (128 + tk)) * 2 + kv) * 64;
#pragma unroll
                for (int i = 0; i < 8; ++i) { const f32x4 k0 = *(const f32x4*)(kr + 8 * i), k1 = *(const f32x4*)(kr + 8 * i + 4);
                    dot += bflo(q[i].x) * k0.x + bfhi(q[i].x) * k0.y + bflo(q[i].y) * k0.z + bfhi(q[i].y) * k0.w + bflo(q[i].z) * k1.x + bfhi(q[i].z) * k1.y + bflo(q[i].w) * k1.z + bfhi(q[i].w) * k1.w; } }
            else valid = false;
            sc[hh] = valid ? dot * 0.125f + relb[t5_bucket(dist) * 8 + head] : -INFINITY;
        }
        const float sk = sinks[head];
        const float mx = fmaxf(wave_max(fmaxf(sc[0], sc[1])), sk);
        const float p0 = __expf(sc[0] - mx), p1 = __expf(sc[1] - mx);
        const float den = wave_sum(p0 + p1) + __expf(sk - mx);
        float acc = 0.f;
        const int nd = samp ? 128 : (t + 1 < 128 ? t + 1 : 128);
        for (int dist = 0; dist < nd; ++dist) {
            const float p = __shfl(dist < 64 ? p0 : p1, dist & 63); const int tk = t - dist; float v;
            if (tk >= 0) v = bf2f(F.PROJ[(size_t)(m - dist) * NPROJ + PV + kv * 64 + lane]);
            else v = F.in[I_CSWAV][(((size_t)seq * 128 + (128 + tk)) * 2 + kv) * 64 + lane];
            acc += p * v;
        }
        F.MIX[(size_t)m * 1024 + 512 + head * 64 + lane] = (bf16)f2bf(acc / den);
    }
}

__device__ __forceinline__ void n5_cross(const Frame& F) {
    const int gw = F.vcu * NWAVES + F.wave, NGW = F.G * NWAVES, lane = F.lane;
    LAS unsigned* qs = (LAS unsigned*)(F.lds + RING_OFF + F.wave * 2048);
    LAS float* ps = (LAS float*)(F.lds + RING_OFF + F.wave * 2048 + 256);
    for (int it = gw; it < M * 4; it += NGW) {
        const int m = it >> 2, head = it & 3; const bool samp = m >= MP; const int seq = samp ? (m - MP) / TS : m / SEQ;
        qs[lane] = *(const unsigned*)(F.QC + (size_t)m * CA + head * 128 + 2 * lane);
        LDS_WAIT(); asm volatile("" ::: "memory");
        float sc[4];
#pragma unroll
        for (int i = 0; i < 4; ++i) { const int j = lane + 64 * i; float dot = 0.f;
            if (!samp) { const bf16* kr = F.MKVB + (size_t)(seq * NMEM + j) * 1024 + head * 128;
#pragma unroll
                for (int c8 = 0; c8 < 16; ++c8) { const v4u q8 = *(const LAS v4u*)(qs + 4 * c8); const v4u k8 = *(const v4u*)(kr + 8 * c8);
                    dot += bflo(q8.x) * bflo(k8.x) + bfhi(q8.x) * bfhi(k8.x) + bflo(q8.y) * bflo(k8.y) + bfhi(q8.y) * bfhi(k8.y)
                         + bflo(q8.z) * bflo(k8.z) + bfhi(q8.z) * bfhi(k8.z) + bflo(q8.w) * bflo(k8.w) + bfhi(q8.w) * bfhi(k8.w); } }
            else { const float* kr = F.in[I_CMEMK] + (((size_t)seq * NMEM + j) * 4 + head) * 128;
#pragma unroll
                for (int c8 = 0; c8 < 16; ++c8) { const v4u q8 = *(const LAS v4u*)(qs + 4 * c8); const f32x4 k0 = *(const f32x4*)(kr + 8 * c8), k1 = *(const f32x4*)(kr + 8 * c8 + 4);
                    dot += bflo(q8.x) * k0.x + bfhi(q8.x) * k0.y + bflo(q8.y) * k0.z + bfhi(q8.y) * k0.w + bflo(q8.z) * k1.x + bfhi(q8.z) * k1.y + bflo(q8.w) * k1.z + bfhi(q8.w) * k1.w; } }
            sc[i] = dot; }
        const float mx = wave_max(fmaxf(fmaxf(sc[0], sc[1]), fmaxf(sc[2], sc[3])));
        float psum = 0.f;
#pragma unroll
        for (int i = 0; i < 4; ++i) { const float p = __expf(sc[i] - mx); ps[lane + 64 * i] = p; psum += p; }
        const float den = wave_sum(psum);
        LDS_WAIT(); asm volatile("" ::: "memory");
        float a0 = 0.f, a1 = 0.f;
        if (!samp) { const bf16* vr = F.MKVB + (size_t)(seq * NMEM) * 1024 + 512 + head * 128 + 2 * lane;
#pragma unroll 8
            for (int j = 0; j < NMEM; ++j) { const float p = ps[j]; const unsigned w = *(const unsigned*)(vr + (size_t)j * 1024); a0 += p * bflo(w); a1 += p * bfhi(w); } }
        else { const float* vr = F.in[I_CMEMV] + ((size_t)seq * NMEM * 4 + head) * 128 + 2 * lane;
#pragma unroll 8
            for (int j = 0; j < NMEM; ++j) { const float p = ps[j]; const float v0 = vr[(size_t)j * 512], v1 = vr[(size_t)j * 512 + 1]; a0 += p * v0; a1 += p * v1; } }
        const float inv = 1.0f / den;
        *(unsigned*)(F.OC + (size_t)m * CA + head * 128 + 2 * lane) = pk2(a0 * inv, a1 * inv);
        LDS_WAIT(); asm volatile("" ::: "memory");
    }
}

__device__ __forceinline__ void p11_final(const Frame& F) {
    const int gw = F.vcu * NWAVES + F.wave, NGW = F.G * NWAVES, lane = F.lane;
    const f32x4 g0 = *(const f32x4*)(F.in[I_GFINAL] + 8 * lane), g1 = *(const f32x4*)(F.in[I_GFINAL] + 8 * lane + 4), g2 = *(const f32x4*)(F.in[I_GFINAL] + 512 + 8 * lane), g3 = *(const f32x4*)(F.in[I_GFINAL] + 512 + 8 * lane + 4);
    for (int m = gw; m < M; m += NGW) {
        const v4u a = *(const v4u*)(F.HB + (size_t)m * DM + 8 * lane), b = *(const v4u*)(F.HB + (size_t)m * DM + 512 + 8 * lane);
        f32x4 v0 = (f32x4){bflo(a.x), bfhi(a.x), bflo(a.y), bfhi(a.y)}, v1 = (f32x4){bflo(a.z), bfhi(a.z), bflo(a.w), bfhi(a.w)};
        f32x4 v2 = (f32x4){bflo(b.x), bfhi(b.x), bflo(b.y), bfhi(b.y)}, v3 = (f32x4){bflo(b.z), bfhi(b.z), bflo(b.w), bfhi(b.w)};
        float s = 0.f;
#pragma unroll
        for (int e = 0; e < 4; ++e) s += (v0[e] * v0[e] + v1[e] * v1[e]) + (v2[e] * v2[e] + v3[e] * v3[e]);
        const float rstd = 1.0f / sqrtf(wave_sum(s) * (1.f / DM) + EPS);
        float* o = F.out + O_Y + (size_t)m * DM + 8 * lane;
        *(f32x4*)(o) = v0 * rstd * g0; *(f32x4*)(o + 4) = v1 * rstd * g1; *(f32x4*)(o + 512) = v2 * rstd * g2; *(f32x4*)(o + 516) = v3 * rstd * g3;
    }
}

typedef short s16x4 __attribute__((ext_vector_type(4)));
typedef unsigned u32x2 __attribute__((ext_vector_type(2)));
#define MFMA16(a, b, c) __builtin_amdgcn_mfma_f32_16x16x32_bf16((a), (b), (c), 0, 0, 0)
__device__ __forceinline__ bf16x8 cat8(s16x4 lo, s16x4 hi) { return __builtin_shufflevector(lo, hi, 0, 1, 2, 3, 4, 5, 6, 7); }
__device__ __forceinline__ bf16x8 pack_p(const f32x4& a, const f32x4& b) {
    v4u w; w.x = pk2(a[0], a[1]); w.y = pk2(a[2], a[3]); w.z = pk2(b[0], b[1]); w.w = pk2(b[2], b[3]); return __builtin_bit_cast(bf16x8, w);
}

constexpr int SW_KSTR = 144, SW_VSTR = 528;
constexpr int SW_K = 0, SW_V = 256 * SW_KSTR, SW_BIAS = SW_V + 64 * SW_VSTR, SW_END = SW_BIAS + 8 * 128 * 4;
__device__ __forceinline__ void swa_item(const LAS unsigned char* lds, const float* sinks, int kt0, int jmin, int tmax, const bf16* qptr, int qpos, int head, bf16* optr, int lane) {
    const int ar = lane & 15, jj = lane >> 4;
    const LAS unsigned char* Kl = lds + SW_K; const LAS unsigned char* Vl = lds + SW_V; const LAS float* biasT = (const LAS float*)(lds + SW_BIAS);
    bf16x8 qf[2];
#pragma unroll
    for (int ks = 0; ks < 2; ++ks) qf[ks] = *(const bf16x8*)(qptr + 32 * ks + 8 * jj);
    f32x4 sacc[10]; sacc[9] = (f32x4){0.f, 0.f, 0.f, 0.f};
#pragma unroll
    for (int kt = 0; kt < 9; ++kt) { sacc[kt] = (f32x4){0.f, 0.f, 0.f, 0.f};
#pragma unroll
        for (int ks = 0; ks < 2; ++ks) { const bf16x8 a = *(const LAS bf16x8*)(Kl + (16 * (kt0 + kt) + ar) * SW_KSTR + 64 * ks + 16 * jj); sacc[kt] = MFMA16(a, qf[ks], sacc[kt]); }
        if (kt & 1) __builtin_amdgcn_sched_barrier(0); }
    float mx = -INFINITY;
#pragma unroll
    for (int kt = 0; kt < 9; ++kt)
#pragma unroll
        for (int r = 0; r < 4; ++r) { const int j = 16 * (kt0 + kt) + 4 * jj + r, dist = 128 + qpos - j; const bool valid = (dist >= 0) && (dist < 128) && (j >= jmin);
            const float s = valid ? sacc[kt][r] * 0.125f + biasT[head * 128 + (dist & 127)] : -INFINITY; sacc[kt][r] = s; mx = fmaxf(mx, s); }
    mx = fmaxf(mx, __shfl_xor(mx, 16)); mx = fmaxf(mx, __shfl_xor(mx, 32));
    const float sk = sinks[head]; mx = fmaxf(mx, sk);
    float sum = 0.f;
#pragma unroll
    for (int kt = 0; kt < 9; ++kt)
#pragma unroll
        for (int r = 0; r < 4; ++r) { const float p = __expf(sacc[kt][r] - mx); sacc[kt][r] = p; sum += p; }
    sum += __shfl_xor(sum, 16); sum += __shfl_xor(sum, 32);
    const float inv = 1.0f / (sum + __expf(sk - mx));
    f32x4 oacc[4];
#pragma unroll
    for (int dt = 0; dt < 4; ++dt) oacc[dt] = (f32x4){0.f, 0.f, 0.f, 0.f};
#pragma unroll
    for (int u = 0; u < 5; ++u) {
        const bf16x8 pb = pack_p(sacc[2 * u], sacc[2 * u + 1]);
        const int T0 = kt0 + 2 * u, T1r = kt0 + 2 * u + 1, T1 = T1r < tmax ? T1r : tmax;
#pragma unroll
        for (int dt = 0; dt < 4; ++dt) {
            const LAS unsigned char* vrow = Vl + (16 * dt + ar) * SW_VSTR + 8 * jj;
            const s16x4 lo = *(const LAS s16x4*)(vrow + 32 * T0), hi = *(const LAS s16x4*)(vrow + 32 * T1);
            oacc[dt] = MFMA16(cat8(lo, hi), pb, oacc[dt]);
        }
        __builtin_amdgcn_sched_barrier(0);
    }
#pragma unroll
    for (int dt = 0; dt < 4; ++dt) { u32x2 w; w.x = pk2(oacc[dt][0] * inv, oacc[dt][1] * inv); w.y = pk2(oacc[dt][2] * inv, oacc[dt][3] * inv); *(u32x2*)(optr + 16 * dt + 4 * jj) = w; }
}
__device__ __forceinline__ void swa_phase(const Frame& F) {
    LAS unsigned char* lds = F.lds + RING_OFF; const int tid = F.tid, lane = F.lane, wave = F.wave;
    LAS float* biasT = (LAS float*)(lds + SW_BIAS);
    for (int idx = tid; idx < 1024; idx += NWAVES * 64) { const int h = idx >> 7, d = idx & 127; biasT[idx] = F.in[I_RELB][t5_bucket(d) * 8 + h]; }
    constexpr int NPU = NBATCH * 32 * 2, NSU = NSS * 2;
    for (int u = F.vcu; u < NPU + NSU; u += F.G) {
        __syncthreads();
        if (u < NPU) {
            const int b = u >> 6, i = (u >> 1) & 31, kv = u & 1; const long m0 = (long)b * SEQ + 128 * i;
#pragma unroll
            for (int r = 0; r < 4; ++r) { const int id = tid + 512 * r, key = id >> 3, ch = id & 7; v4u v = (v4u){0u, 0u, 0u, 0u};
                if (i > 0 || key >= 128) v = *(const v4u*)(F.PROJ + (size_t)(m0 - 128 + key) * NPROJ + PK + kv * 64 + 8 * ch);
                *(LAS v4u*)(lds + SW_K + key * SW_KSTR + 16 * ch) = v; }
            { const int kg = tid >> 3, ch = tid & 7; v4u v[4];
#pragma unroll
              for (int r = 0; r < 4; ++r) { const int key = 4 * kg + r; v[r] = (v4u){0u, 0u, 0u, 0u}; if (i > 0 || key >= 128) v[r] = *(const v4u*)(F.PROJ + (size_t)(m0 - 128 + key) * NPROJ + PV + kv * 64 + 8 * ch); }
              const unsigned w0[4] = {v[0].x, v[0].y, v[0].z, v[0].w}, w1[4] = {v[1].x, v[1].y, v[1].z, v[1].w}, w2[4] = {v[2].x, v[2].y, v[2].z, v[2].w}, w3[4] = {v[3].x, v[3].y, v[3].z, v[3].w};
#pragma unroll
              for (int e2 = 0; e2 < 4; ++e2) {
                  u32x2 lo, hi; lo.x = (w0[e2] & 0xffffu) | (w1[e2] << 16); lo.y = (w2[e2] & 0xffffu) | (w3[e2] << 16);
                  hi.x = (w0[e2] >> 16) | (w1[e2] & 0xffff0000u); hi.y = (w2[e2] >> 16) | (w3[e2] & 0xffff0000u);
                  *(LAS u32x2*)(lds + SW_V + (8 * ch + 2 * e2) * SW_VSTR + 8 * kg) = lo; *(LAS u32x2*)(lds + SW_V + (8 * ch + 2 * e2 + 1) * SW_VSTR + 8 * kg) = hi; } }
            __syncthreads();
            const int qt = wave, c = lane & 15; const long mq = m0 + 16 * qt + c;
#pragma unroll 1
            for (int g = 0; g < 4; ++g) { const int head = kv * 4 + g;
                swa_item(lds, F.in[I_SINKS], qt, i == 0 ? 128 : 0, 15, F.PROJ + (size_t)mq * NPROJ + PQ + head * 64, 16 * qt + c, head, F.MIX + (size_t)mq * 1024 + 512 + head * 64, lane); }
        } else {
            const int su = u - NPU, s = su >> 1, kv = su & 1;
#pragma unroll
            for (int r = 0; r < 4; ++r) { const int id = tid + 512 * r, key = id >> 4, c4 = id & 15; const f32x4 v = *(const f32x4*)(F.in[I_CSWAK] + (((size_t)s * 128 + key) * 2 + kv) * 64 + 4 * c4);
                u32x2 w; w.x = pk2(v.x, v.y); w.y = pk2(v.z, v.w); *(LAS u32x2*)(lds + SW_K + key * SW_KSTR + 8 * c4) = w; }
            if (tid < 128) { const int key = 128 + (tid >> 3), ch = tid & 7; v4u v = (v4u){0u, 0u, 0u, 0u};
                if (key < 136) v = *(const v4u*)(F.PROJ + (size_t)(MP + s * TS + key - 128) * NPROJ + PK + kv * 64 + 8 * ch);
                *(LAS v4u*)(lds + SW_K + key * SW_KSTR + 16 * ch) = v; }
            { const int kg = tid >> 4, c4 = tid & 15; f32x4 v[4];
#pragma unroll
              for (int r = 0; r < 4; ++r) v[r] = *(const f32x4*)(F.in[I_CSWAV] + (((size_t)s * 128 + 4 * kg + r) * 2 + kv) * 64 + 4 * c4);
#pragma unroll
              for (int e = 0; e < 4; ++e) { u32x2 w; w.x = pk2(v[0][e], v[1][e]); w.y = pk2(v[2][e], v[3][e]); *(LAS u32x2*)(lds + SW_V + (4 * c4 + e) * SW_VSTR + 8 * kg) = w; } }
            if (tid < 32) { const int kg = 32 + (tid >> 3), ch = tid & 7; v4u v[4];
#pragma unroll
              for (int r = 0; r < 4; ++r) { const int key = 4 * kg + r; v[r] = (v4u){0u, 0u, 0u, 0u}; if (key < 136) v[r] = *(const v4u*)(F.PROJ + (size_t)(MP + s * TS + key - 128) * NPROJ + PV + kv * 64 + 8 * ch); }
              const unsigned w0[4] = {v[0].x, v[0].y, v[0].z, v[0].w}, w1[4] = {v[1].x, v[1].y, v[1].z, v[1].w}, w2[4] = {v[2].x, v[2].y, v[2].z, v[2].w}, w3[4] = {v[3].x, v[3].y, v[3].z, v[3].w};
#pragma unroll
              for (int e2 = 0; e2 < 4; ++e2) {
                  u32x2 lo, hi; lo.x = (w0[e2] & 0xffffu) | (w1[e2] << 16); lo.y = (w2[e2] & 0xffffu) | (w3[e2] << 16);
                  hi.x = (w0[e2] >> 16) | (w1[e2] & 0xffff0000u); hi.y = (w2[e2] >> 16) | (w3[e2] & 0xffff0000u);
                  *(LAS u32x2*)(lds + SW_V + (8 * ch + 2 * e2) * SW_VSTR + 8 * kg) = lo; *(LAS u32x2*)(lds + SW_V + (8 * ch + 2 * e2 + 1) * SW_VSTR + 8 * kg) = hi; } }
            __syncthreads();
            if (wave < 2) { const int c = lane & 15, t = c & 7, head = kv * 4 + 2 * wave + (c >> 3); const long mq = (long)MP + s * TS + t;
                swa_item(lds, F.in[I_SINKS], 0, 0, 8, F.PROJ + (size_t)mq * NPROJ + PQ + head * 64, t, head, F.MIX + (size_t)mq * 1024 + 512 + head * 64, lane); }
        }
    }
    __syncthreads();
}

constexpr int SD_TSTR = 272;
constexpr int SD_DTS = 0, SD_CSS = 4096, SD_A0 = 8192;
constexpr int S1_XT = SD_A0, S1_BT = S1_XT + 256 * SD_TSTR, S1_END = S1_BT + 128 * SD_TSTR;
constexpr int S2_C = SD_A0, S2_B = S2_C + 128 * SD_TSTR, S2_XT = S2_B + 128 * SD_TSTR, S2_RED = S2_XT + 256 * SD_TSTR, S2_END = S2_RED + 4 * 8 * 16 * 4;
static_assert(S2_END <= RING_BYTES && S1_END <= RING_BYTES, "SSD LDS map");

__device__ __forceinline__ void ssd_dtcs(const Frame& F, long m0) {
    const int h = F.wave; int lane = F.lane; asm volatile("" : "+v"(lane));
    LAS float* DTS = (LAS float*)(F.lds + SD_DTS); LAS float* CSS = (LAS float*)(F.lds + SD_CSS);
    const float A = -__expf(F.in[I_ALOG][h]), dtb = F.in[I_DTB][h];
    const float dt0 = softplus(F.DT[(size_t)(m0 + 2 * lane) * 8 + h] + dtb), dt1 = softplus(F.DT[(size_t)(m0 + 2 * lane + 1) * 8 + h] + dtb);
    const float a0 = dt0 * A, a1 = dt1 * A;
    float x = a0 + a1;
#pragma unroll
    for (int o = 1; o < 64; o <<= 1) { const float y = __shfl_up(x, o); if (lane >= o) x += y; }
    DTS[h * 128 + 2 * lane] = dt0; DTS[h * 128 + 2 * lane + 1] = dt1; CSS[h * 128 + 2 * lane] = x - a1; CSS[h * 128 + 2 * lane + 1] = x;
}
__device__ __forceinline__ void ssd_conv8(const Frame& F, long m0, bool first, int s0, int col0, float (&res)[8][8]) {
    const float* cw = F.in[I_CONVW]; const float* cb = F.in[I_CONVB];
    float w[4][8], bias[8];
#pragma unroll
    for (int k = 0; k < 4; ++k) { const f32x4 a = *(const f32x4*)(cw + k * 1024 + col0), b = *(const f32x4*)(cw + k * 1024 + col0 + 4);
        w[k][0] = a.x; w[k][1] = a.y; w[k][2] = a.z; w[k][3] = a.w; w[k][4] = b.x; w[k][5] = b.y; w[k][6] = b.z; w[k][7] = b.w; }
    { const f32x4 a = *(const f32x4*)(cb + col0), b = *(const f32x4*)(cb + col0 + 4); bias[0] = a.x; bias[1] = a.y; bias[2] = a.z; bias[3] = a.w; bias[4] = b.x; bias[5] = b.y; bias[6] = b.z; bias[7] = b.w; }
    v4u raw[11];
#pragma unroll
    for (int i = 0; i < 11; ++i) { raw[i] = (v4u){0u, 0u, 0u, 0u}; if (!(first && s0 + i < 3)) raw[i] = *(const v4u*)(F.PROJ + (size_t)(m0 + s0 - 3 + i) * NPROJ + PXBC + col0); }
#pragma unroll
    for (int s = 0; s < 8; ++s) {
#pragma unroll
        for (int e = 0; e < 8; ++e) res[s][e] = bias[e];
#pragma unroll
        for (int k = 0; k < 4; ++k) { const v4u r = raw[s + k];
            res[s][0] += w[k][0] * bflo(r.x); res[s][1] += w[k][1] * bfhi(r.x); res[s][2] += w[k][2] * bflo(r.y); res[s][3] += w[k][3] * bfhi(r.y);
            res[s][4] += w[k][4] * bflo(r.z); res[s][5] += w[k][5] * bfhi(r.z); res[s][6] += w[k][6] * bflo(r.w); res[s][7] += w[k][7] * bfhi(r.w); }
#pragma unroll
        for (int e = 0; e < 8; ++e) res[s][e] = silu(res[s][e]);
    }
}
__device__ __forceinline__ void ssd_put_T(LAS unsigned char* img, int row0, int s0, const float (&res)[8][8]) {
#pragma unroll
    for (int e = 0; e < 8; ++e) { v4u o; o.x = pk2(res[0][e], res[1][e]); o.y = pk2(res[2][e], res[3][e]); o.z = pk2(res[4][e], res[5][e]); o.w = pk2(res[6][e], res[7][e]);
        *(LAS v4u*)(img + (row0 + e) * SD_TSTR + 2 * s0) = o; }
}
__device__ __forceinline__ void ssd_put_R(LAS unsigned char* img, int s0, int c0, const float (&res)[8][8]) {
#pragma unroll
    for (int s = 0; s < 8; ++s) { v4u o; o.x = pk2(res[s][0], res[s][1]); o.y = pk2(res[s][2], res[s][3]); o.z = pk2(res[s][4], res[s][5]); o.w = pk2(res[s][6], res[s][7]);
        *(LAS v4u*)(img + (s0 + s) * SD_TSTR + 2 * c0) = o; }
}

__device__ __forceinline__ void ssd_states(const Frame& F) {
    LAS unsigned char* lds = F.lds + RING_OFF; const int wave = F.wave;
    const LAS float* DTS = (const LAS float*)(lds + SD_DTS); const LAS float* CSS = (const LAS float*)(lds + SD_CSS);
    for (int u = F.vcu; u < NBATCH * 32; u += F.G) {
        int tid = F.tid; asm volatile("" : "+v"(tid));
        const int lane = tid & 63, ar = lane & 15, jj = lane >> 4;
        const int b = u >> 5, c = u & 31; const long m0 = (long)b * SEQ + 128 * c;
        __syncthreads();
        ssd_dtcs(F, m0);
        __syncthreads();
        if (tid < 8) F.CD[u * 8 + tid] = __expf(CSS[tid * 128 + 127]);
#pragma unroll 1
        for (int g = 0; g < 2; ++g) {
            if (g) __syncthreads();
            { const int sb = tid & 15, chunk = tid >> 4, h = 4 * g + (chunk >> 3); float res[8][8];
              ssd_conv8(F, m0, c == 0, 8 * sb, g * 256 + 8 * chunk, res);
              const float cl = CSS[h * 128 + 127];
#pragma unroll
              for (int s = 0; s < 8; ++s) { const float wgt = DTS[h * 128 + 8 * sb + s] * __expf(cl - CSS[h * 128 + 8 * sb + s]);
#pragma unroll
                  for (int e = 0; e < 8; ++e) res[s][e] *= wgt; }
              ssd_put_T(lds + S1_XT, 8 * chunk, 8 * sb, res); }
            __builtin_amdgcn_sched_barrier(0);
            if (tid < 256) { const int sb = tid & 15, chunk = tid >> 4; float res[8][8];
              ssd_conv8(F, m0, c == 0, 8 * sb, 512 + g * 128 + 8 * chunk, res);
              ssd_put_T(lds + S1_BT, 8 * chunk, 8 * sb, res); }
            __syncthreads();
            f32x4 acc[2][8];
#pragma unroll
            for (int i = 0; i < 2; ++i)
#pragma unroll
                for (int nt = 0; nt < 8; ++nt) acc[i][nt] = (f32x4){0.f, 0.f, 0.f, 0.f};
#pragma unroll
            for (int ks = 0; ks < 4; ++ks) {
                bf16x8 a[2];
#pragma unroll
                for (int i = 0; i < 2; ++i) a[i] = *(const LAS bf16x8*)(lds + S1_XT + (16 * (2 * wave + i) + ar) * SD_TSTR + 64 * ks + 16 * jj);
#pragma unroll
                for (int nt = 0; nt < 8; ++nt) { const bf16x8 bf = *(const LAS bf16x8*)(lds + S1_BT + (16 * nt + ar) * SD_TSTR + 64 * ks + 16 * jj);
                    acc[0][nt] = MFMA16(a[0], bf, acc[0][nt]); acc[1][nt] = MFMA16(a[1], bf, acc[1][nt]); }
                __builtin_amdgcn_sched_barrier(0);
            }
            float* stp = F.ST + ((size_t)u * 8 + 4 * g) * 8192 + (size_t)(32 * wave + 4 * jj) * 128 + ar;
#pragma unroll
            for (int i = 0; i < 2; ++i)
#pragma unroll
                for (int nt = 0; nt < 8; ++nt)
#pragma unroll
                    for (int r = 0; r < 4; ++r) stp[(size_t)(16 * i + r) * 128 + 16 * nt] = acc[i][nt][r];
        }
    }
    __syncthreads();
}

__device__ __forceinline__ void ssd_scan(const Frame& F) {
    for (int e = F.vcu * (NWAVES * 64) + F.tid; e < NBATCH * 16384; e += F.G * NWAVES * 64) {
        const int b = e >> 14, rem = e & 16383, h = rem >> 11;
        f32x4 cur = (f32x4){0.f, 0.f, 0.f, 0.f};
#pragma unroll 8
        for (int c = 0; c < 32; ++c) {
            const size_t off = (size_t)(b * 32 + c) * 65536 + (size_t)rem * 4;
            u32x2 w; w.x = pk2(cur.x, cur.y); w.y = pk2(cur.z, cur.w); *(u32x2*)(F.HS + off) = w;
            const f32x4 st = *(const f32x4*)(F.ST + off); const float cd = F.CD[(b * 32 + c) * 8 + h];
            cur = cur * cd + st;
        }
        *(f32x4*)(F.out + O_PSSM + (size_t)b * 65536 + (size_t)rem * 4) = cur;
    }
}

__device__ __forceinline__ void ssd_output(const Frame& F) {
    LAS unsigned char* lds = F.lds + RING_OFF; const int wave = F.wave;
    const LAS float* DTS = (const LAS float*)(lds + SD_DTS); const LAS float* CSS = (const LAS float*)(lds + SD_CSS); LAS float* RED = (LAS float*)(lds + S2_RED);
    const float* gn = F.in[I_GSSD];
    for (int u = F.vcu; u < NBATCH * 32; u += F.G) {
        int tid = F.tid; asm volatile("" : "+v"(tid));
        const int lane = tid & 63, ar = lane & 15, jj = lane >> 4;
        const int b = u >> 5, c = u & 31; const long m0 = (long)b * SEQ + 128 * c;
        __syncthreads();
        ssd_dtcs(F, m0);
#pragma unroll 1
        for (int g = 0; g < 2; ++g) {
            __syncthreads();
            { const int sb = tid & 15, chunk = tid >> 4; float res[8][8];
              ssd_conv8(F, m0, c == 0, 8 * sb, g * 256 + 8 * chunk, res);
              ssd_put_T(lds + S2_XT, 8 * chunk, 8 * sb, res); }
            __builtin_amdgcn_sched_barrier(0);
            { const int t2 = tid & 255, chunk = t2 & 15, sb = t2 >> 4; float res[8][8];
              ssd_conv8(F, m0, c == 0, 8 * sb, (tid < 256 ? 512 : 768) + g * 128 + 8 * chunk, res);
              ssd_put_R(lds + (tid < 256 ? S2_B : S2_C), 8 * sb, 8 * chunk, res); }
            __syncthreads();
            const int pi = wave & 3, hh = wave >> 2;
#pragma unroll 1
            for (int it = 0; it < 2; ++it) {
                const int qt = it ? 7 - pi : pi, q = 16 * qt + ar;
                bf16x8 cf[4];
#pragma unroll
                for (int ks = 0; ks < 4; ++ks) cf[ks] = *(const LAS bf16x8*)(lds + S2_C + q * SD_TSTR + 64 * ks + 16 * jj);
                f32x4 cbt[8];
#pragma unroll
                for (int st = 0; st < 8; ++st) { cbt[st] = (f32x4){0.f, 0.f, 0.f, 0.f};
                    if (st <= qt) {
#pragma unroll
                        for (int ks = 0; ks < 4; ++ks) { const bf16x8 a = *(const LAS bf16x8*)(lds + S2_B + (16 * st + ar) * SD_TSTR + 64 * ks + 16 * jj); cbt[st] = MFMA16(a, cf[ks], cbt[st]); } }
                    __builtin_amdgcn_sched_barrier(0); }
                float ss = 0.f;
#pragma unroll 1
                for (int hs = 0; hs < 2; ++hs) {
                    const int hl = 2 * hh + hs, hg = 4 * g + hl;
                    const bf16* hsp = F.HS + ((size_t)u * 8 + hg) * 8192 + (size_t)ar * 128 + 8 * jj;
                    bf16x8 hf[4][4];
#pragma unroll
                    for (int pt = 0; pt < 4; ++pt)
#pragma unroll
                        for (int ks = 0; ks < 4; ++ks) hf[pt][ks] = *(const bf16x8*)(hsp + (size_t)(16 * pt) * 128 + 32 * ks);
                    u32x2 zr[4];
#pragma unroll
                    for (int pt = 0; pt < 4; ++pt) zr[pt] = *(const u32x2*)(F.PROJ + (size_t)(m0 + q) * NPROJ + PZ + hg * 64 + 16 * pt + 4 * jj);
                    const float csq = CSS[hg * 128 + q], eq = __expf(csq);
                    f32x4 acc[4];
#pragma unroll
                    for (int pt = 0; pt < 4; ++pt) acc[pt] = (f32x4){0.f, 0.f, 0.f, 0.f};
                    __builtin_amdgcn_sched_barrier(0);
#pragma unroll
                    for (int uu = 0; uu < 4; ++uu) {
                        if (2 * uu <= qt) {
                            f32x4 mA, mB;
                            { const int sbase = 32 * uu + 4 * jj; const f32x4 css = *(const LAS f32x4*)(CSS + hg * 128 + sbase), dts = *(const LAS f32x4*)(DTS + hg * 128 + sbase);
#pragma unroll
                              for (int r = 0; r < 4; ++r) { const int s = sbase + r; const float d = fminf(csq - css[r], 0.f); mA[r] = (s <= q) ? cbt[2 * uu][r] * __expf(d) * dts[r] : 0.f; } }
                            { const int sbase = 32 * uu + 16 + 4 * jj; const f32x4 css = *(const LAS f32x4*)(CSS + hg * 128 + sbase), dts = *(const LAS f32x4*)(DTS + hg * 128 + sbase);
#pragma unroll
                              for (int r = 0; r < 4; ++r) { const int s = sbase + r; const float d = fminf(csq - css[r], 0.f); mB[r] = (s <= q) ? cbt[2 * uu + 1][r] * __expf(d) * dts[r] : 0.f; } }
                            const bf16x8 pb = pack_p(mA, mB);
#pragma unroll
                            for (int pt = 0; pt < 4; ++pt) { const LAS unsigned char* xrow = lds + S2_XT + (hl * 64 + 16 * pt + ar) * SD_TSTR + 64 * uu + 8 * jj;
                                const s16x4 lo = *(const LAS s16x4*)(xrow), hi = *(const LAS s16x4*)(xrow + 32); acc[pt] = MFMA16(cat8(lo, hi), pb, acc[pt]); }
                        }
                        __builtin_amdgcn_sched_barrier(0);
                    }
                    const float dsk = F.in[I_DSKIP][hg];
#pragma unroll
                    for (int pt = 0; pt < 4; ++pt) {
                        f32x4 ao = (f32x4){0.f, 0.f, 0.f, 0.f};
#pragma unroll
                        for (int ks = 0; ks < 4; ++ks) ao = MFMA16(hf[pt][ks], cf[ks], ao);
                        const float z[4] = {bflo(zr[pt].x), bfhi(zr[pt].x), bflo(zr[pt].y), bfhi(zr[pt].y)};
                        float y[4];
#pragma unroll
                        for (int r = 0; r < 4; ++r) { const float xs = bf2f(*(const LAS unsigned short*)(lds + S2_XT + (hl * 64 + 16 * pt + 4 * jj + r) * SD_TSTR + 2 * q));
                            y[r] = (acc[pt][r] + eq * ao[r] + dsk * xs) * silu(z[r]); ss += y[r] * y[r]; }
                        u32x2 w; w.x = pk2(y[0], y[1]); w.y = pk2(y[2], y[3]);
                        *(u32x2*)(F.MIX + (size_t)(m0 + q) * 1024 + hg * 64 + 16 * pt + 4 * jj) = w;
                    }
                }
                ss += __shfl_xor(ss, 16); ss += __shfl_xor(ss, 32);
                LAS float* red = RED + (2 * g + it) * 128;
                if (jj == 0) red[wave * 16 + ar] = ss;
                __syncthreads();
                const float tot = ss + red[(wave ^ 4) * 16 + ar];
                const float rs = 1.0f / sqrtf(tot * (1.0f / 256.0f) + EPS);
#pragma unroll 1
                for (int hs = 0; hs < 2; ++hs) { const int hg = 4 * g + 2 * hh + hs;
#pragma unroll
                    for (int pt = 0; pt < 4; ++pt) { const int col = hg * 64 + 16 * pt + 4 * jj; const f32x4 gv = *(const f32x4*)(gn + col);
                        u32x2* mp = (u32x2*)(F.MIX + (size_t)(m0 + q) * 1024 + col); const u32x2 v = *mp;
                        u32x2 w; w.x = pk2(bflo(v.x) * rs * gv.x, bfhi(v.x) * rs * gv.y); w.y = pk2(bflo(v.y) * rs * gv.z, bfhi(v.y) * rs * gv.w);
                        *mp = w; } }
            }
        }
    }
    __syncthreads();
}
constexpr int CX_KSTR = 272, CX_VSTR = 528;
constexpr int CX_K = 0, CX_V = 256 * CX_KSTR, CX_END = CX_V + 128 * CX_VSTR;
__device__ __forceinline__ void cx_item(const LAS unsigned char* lds, const bf16* qptr, bf16* optr, bool ostore, int lane) {
    const int ar = lane & 15, jj = lane >> 4;
    const LAS unsigned char* Kl = lds + CX_K; const LAS unsigned char* Vl = lds + CX_V;
    bf16x8 qf[4];
#pragma unroll
    for (int ks = 0; ks < 4; ++ks) qf[ks] = *(const bf16x8*)(qptr + 32 * ks + 8 * jj);
    f32x4 sacc[16];
#pragma unroll
    for (int kt = 0; kt < 16; ++kt) { sacc[kt] = (f32x4){0.f, 0.f, 0.f, 0.f};
#pragma unroll
        for (int ks = 0; ks < 4; ++ks) { const bf16x8 a = *(const LAS bf16x8*)(Kl + (16 * kt + ar) * CX_KSTR + 64 * ks + 16 * jj); sacc[kt] = MFMA16(a, qf[ks], sacc[kt]); }
        __builtin_amdgcn_sched_barrier(0); }
    float mx = -INFINITY;
#pragma unroll
    for (int kt = 0; kt < 16; ++kt)
#pragma unroll
        for (int r = 0; r < 4; ++r) mx = fmaxf(mx, sacc[kt][r]);
    mx = fmaxf(mx, __shfl_xor(mx, 16)); mx = fmaxf(mx, __shfl_xor(mx, 32));
    float sum = 0.f;
#pragma unroll
    for (int kt = 0; kt < 16; ++kt)
#pragma unroll
        for (int r = 0; r < 4; ++r) { const float p = __expf(sacc[kt][r] - mx); sacc[kt][r] = p; sum += p; }
    sum += __shfl_xor(sum, 16); sum += __shfl_xor(sum, 32);
    const float inv = 1.0f / sum;
    f32x4 oacc[8];
#pragma unroll
    for (int dt = 0; dt < 8; ++dt) oacc[dt] = (f32x4){0.f, 0.f, 0.f, 0.f};
#pragma unroll
    for (int u = 0; u < 8; ++u) {
        const bf16x8 pb = pack_p(sacc[2 * u], sacc[2 * u + 1]);
#pragma unroll
        for (int dt = 0; dt < 8; ++dt) {
            const LAS unsigned char* vrow = Vl + (16 * dt + ar) * CX_VSTR + 8 * jj + 64 * u;
            const s16x4 lo = *(const LAS s16x4*)(vrow), hi = *(const LAS s16x4*)(vrow + 32);
            oacc[dt] = MFMA16(cat8(lo, hi), pb, oacc[dt]);
        }
        __builtin_amdgcn_sched_barrier(0);
    }
    if (ostore) {
#pragma unroll
        for (int dt = 0; dt < 8; ++dt) { u32x2 w; w.x = pk2(oacc[dt][0] * inv, oacc[dt][1] * inv); w.y = pk2(oacc[dt][2] * inv, oacc[dt][3] * inv); *(u32x2*)(optr + 16 * dt + 4 * jj) = w; }
    }
}
__device__ __forceinline__ void cx_phase(const Frame& F) {
    LAS unsigned char* lds = F.lds + RING_OFF; const int tid = F.tid, lane = F.lane, wave = F.wave;
    constexpr int NPU = NBATCH * 4 * 8, NSU = NSS * 4;
    for (int u = F.vcu; u < NPU + NSU; u += F.G) {
        __syncthreads();
        if (u < NPU) {
            const int b = u >> 5, head = (u >> 3) & 3, qc = u & 7;
#pragma unroll
            for (int r = 0; r < 8; ++r) { const int id = tid + 512 * r, key = id >> 4, ch = id & 15;
                *(LAS v4u*)(lds + CX_K + key * CX_KSTR + 16 * ch) = *(const v4u*)(F.MKVB + (size_t)(b * NMEM + key) * 1024 + head * 128 + 8 * ch); }
#pragma unroll
            for (int r2 = 0; r2 < 2; ++r2) { const int id = tid + 512 * r2, kg = id >> 4, ch = id & 15; v4u v[4];
#pragma unroll
              for (int r = 0; r < 4; ++r) v[r] = *(const v4u*)(F.MKVB + (size_t)(b * NMEM + 4 * kg + r) * 1024 + 512 + head * 128 + 8 * ch);
              const unsigned w0[4] = {v[0].x, v[0].y, v[0].z, v[0].w}, w1[4] = {v[1].x, v[1].y, v[1].z, v[1].w}, w2[4] = {v[2].x, v[2].y, v[2].z, v[2].w}, w3[4] = {v[3].x, v[3].y, v[3].z, v[3].w};
#pragma unroll
              for (int e2 = 0; e2 < 4; ++e2) {
                  u32x2 lo, hi; lo.x = (w0[e2] & 0xffffu) | (w1[e2] << 16); lo.y = (w2[e2] & 0xffffu) | (w3[e2] << 16);
                  hi.x = (w0[e2] >> 16) | (w1[e2] & 0xffff0000u); hi.y = (w2[e2] >> 16) | (w3[e2] & 0xffff0000u);
                  *(LAS u32x2*)(lds + CX_V + (8 * ch + 2 * e2) * CX_VSTR + 8 * kg) = lo; *(LAS u32x2*)(lds + CX_V + (8 * ch + 2 * e2 + 1) * CX_VSTR + 8 * kg) = hi; } }
            __syncthreads();
#pragma unroll 1
            for (int i = 0; i < 4; ++i) { const long mq = (long)b * SEQ + 512 * qc + 16 * (4 * wave + i) + (lane & 15);
                cx_item(lds, F.QC + (size_t)mq * CA + head * 128, F.OC + (size_t)mq * CA + head * 128, true, lane); }
        } else {
            const int su = u - NPU, s = su >> 2, head = su & 3;
#pragma unroll
            for (int r = 0; r < 16; ++r) { const int id = tid + 512 * r, key = id >> 5, c4 = id & 31; const f32x4 v = *(const f32x4*)(F.in[I_CMEMK] + (((size_t)s * NMEM + key) * 4 + head) * 128 + 4 * c4);
                u32x2 w; w.x = pk2(v.x, v.y); w.y = pk2(v.z, v.w); *(LAS u32x2*)(lds + CX_K + key * CX_KSTR + 8 * c4) = w; }
#pragma unroll
            for (int r2 = 0; r2 < 4; ++r2) { const int id = tid + 512 * r2, kg = id >> 5, c4 = id & 31; f32x4 v[4];
#pragma unroll
              for (int r = 0; r < 4; ++r) v[r] = *(const f32x4*)(F.in[I_CMEMV] + (((size_t)s * NMEM + 4 * kg + r) * 4 + head) * 128 + 4 * c4);
#pragma unroll
              for (int e = 0; e < 4; ++e) { u32x2 w; w.x = pk2(v[0][e], v[1][e]); w.y = pk2(v[2][e], v[3][e]); *(LAS u32x2*)(lds + CX_V + (4 * c4 + e) * CX_VSTR + 8 * kg) = w; } }
            __syncthreads();
            if (wave == 0) { const int c = lane & 15; const long mq = (long)MP + s * TS + (c & 7);
                cx_item(lds, F.QC + (size_t)mq * CA + head * 128, F.OC + (size_t)mq * CA + head * 128, c < 8, lane); }
        }
    }
    __syncthreads();
}
template <class Epi> __device__ __forceinline__ void skinny_gemm(const Frame& F, const bf16* A, int K, const bf16* Bt, int ncb, const Epi& E, int first_wg) {
    const int lane = F.lane, ar = lane & 15, jj = lane >> 4;
    for (int pc = (int)((blockIdx.x + F.G - first_wg) % F.G); pc < 8 * ncb; pc += F.G) {
        const int rb = pc / ncb, cb = pc % ncb, row = MP + 128 * rb + 16 * F.wave + ar;
        const bf16* ap = A + (size_t)row * K + 8 * jj;
        const bf16* bp0 = Bt + (size_t)(E.brow(cb, 0) + ar) * K + 8 * jj; const bf16* bp1 = Bt + (size_t)(E.brow(cb, 1) + ar) * K + 8 * jj;
        const bf16* bp2 = Bt + (size_t)(E.brow(cb, 2) + ar) * K + 8 * jj; const bf16* bp3 = Bt + (size_t)(E.brow(cb, 3) + ar) * K + 8 * jj;
        f32x4 acc[4];
#pragma unroll
        for (int t = 0; t < 4; ++t) acc[t] = (f32x4){0.f, 0.f, 0.f, 0.f};
#pragma unroll 4
        for (int ks = 0; ks < K / 32; ++ks) { const bf16x8 a = *(const bf16x8*)(ap + 32 * ks);
            const bf16x8 b0 = *(const bf16x8*)(bp0 + 32 * ks), b1 = *(const bf16x8*)(bp1 + 32 * ks), b2 = *(const bf16x8*)(bp2 + 32 * ks), b3 = *(const bf16x8*)(bp3 + 32 * ks);
            acc[0] = MFMA16(b0, a, acc[0]); acc[1] = MFMA16(b1, a, acc[1]); acc[2] = MFMA16(b2, a, acc[2]); acc[3] = MFMA16(b3, a, acc[3]); }
        E.store(acc, row, cb, jj);
    }
}
__device__ __forceinline__ u32x2 pack4(const f32x4& v) { u32x2 w; w.x = pk2(v[0], v[1]); w.y = pk2(v[2], v[3]); return w; }
__device__ __forceinline__ float sk_rstd(const float* ssq, int row) {
    const f32x4 a = *(const f32x4*)(ssq + (size_t)row * 16), b = *(const f32x4*)(ssq + (size_t)row * 16 + 4), c = *(const f32x4*)(ssq + (size_t)row * 16 + 8), d = *(const f32x4*)(ssq + (size_t)row * 16 + 12);
    const float s = ((a.x + a.y) + (a.z + a.w)) + ((b.x + b.y) + (b.z + b.w)) + ((c.x + c.y) + (c.z + c.w)) + ((d.x + d.y) + (d.z + d.w));
    return 1.0f / sqrtf(s * (1.0f / 1024.0f) + EPS);
}
struct SkBf16 { bf16* O; int ldc;
    __device__ __forceinline__ int brow(int cb, int t) const { return 64 * cb + 16 * t; }
    __device__ __forceinline__ void store(const f32x4 (&acc)[4], int row, int cb, int jj) const {
#pragma unroll
        for (int t = 0; t < 4; ++t) *(u32x2*)(O + (size_t)row * ldc + 64 * cb + 16 * t + 4 * jj) = pack4(acc[t]); } };
struct SkScale { bf16* O; int ldc; const float* ssq; float scale;
    __device__ __forceinline__ int brow(int cb, int t) const { return 64 * cb + 16 * t; }
    __device__ __forceinline__ void store(const f32x4 (&acc)[4], int row, int cb, int jj) const { const float r = sk_rstd(ssq, row) * scale;
#pragma unroll
        for (int t = 0; t < 4; ++t) *(u32x2*)(O + (size_t)row * ldc + 64 * cb + 16 * t + 4 * jj) = pack4(acc[t] * r); } };
template <bool BASE_BF16> struct SkResid { const void* base; size_t base_row0; bf16* ob; float* ssq;
    __device__ __forceinline__ int brow(int cb, int t) const { return 64 * cb + 16 * t; }
    __device__ __forceinline__ void store(const f32x4 (&acc)[4], int row, int cb, int jj) const { float ss = 0.f;
#pragma unroll
        for (int t = 0; t < 4; ++t) { const int c = 64 * cb + 16 * t + 4 * jj; f32x4 b;
            if (BASE_BF16) { const u32x2 w = *(const u32x2*)((const bf16*)base + ((size_t)row - base_row0) * 1024 + c); b = (f32x4){bflo(w.x), bfhi(w.x), bflo(w.y), bfhi(w.y)}; }
            else b = *(const f32x4*)((const float*)base + ((size_t)row - base_row0) * 1024 + c);
            const f32x4 v = b + acc[t]; ss += (v[0] * v[0] + v[1] * v[1]) + (v[2] * v[2] + v[3] * v[3]);
            *(u32x2*)(ob + (size_t)row * 1024 + c) = pack4(v); }
        ss += __shfl_xor(ss, 16); ss += __shfl_xor(ss, 32);
        if (jj == 0) ssq[(size_t)row * 16 + cb] = ss; } };
struct SkSwiGLU { bf16* O; const float* ssq;
    __device__ __forceinline__ int brow(int cb, int t) const { const int f0 = 32 * cb; return (f0 >> 7) * 256 + (f0 & 127) + (t & 1) * 16 + (t >> 1) * 128; }
    __device__ __forceinline__ void store(const f32x4 (&acc)[4], int row, int cb, int jj) const { const float r = sk_rstd(ssq, row);
#pragma unroll
        for (int t = 0; t < 2; ++t) { f32x4 h;
#pragma unroll
            for (int e = 0; e < 4; ++e) { const float g = acc[t][e] * r, up = acc[t + 2][e] * r; h[e] = silu(g) * up; }
            *(u32x2*)(O + (size_t)row * DFF + 32 * cb + 16 * t + 4 * jj) = pack4(h); } } };

#ifndef MK_N_LAUNCHES
#define MK_N_LAUNCHES 1
#endif
constexpr int NPH = 12;
constexpr int N_LAUNCHES = MK_N_LAUNCHES;
struct Args { const float* in[31]; float* out; unsigned char* ws; int ph_lo, ph_hi, li, pad; };
__global__ void __launch_bounds__(NWAVES * 64, 2) skel_fwd(Args args) {
    extern __shared__ __attribute__((aligned(16))) unsigned char lds[];
    Frame F;
    F.lds = (LAS unsigned char*)lds;
    F.MISC = (volatile LAS unsigned*)(F.lds + MISC_OFF);
    F.tid = threadIdx.x; F.lane = F.tid & 63; F.wave = __builtin_amdgcn_readfirstlane(F.tid >> 6);
    F.G = gridDim.x; { const int bx = blockIdx.x; F.vcu = (F.G % 8 == 0) ? (bx % 8) * (F.G / 8) + bx / 8 : bx; }
    unsigned char* ws = args.ws;
    F.ctl = (gu32*)(ws + WS_CTL);
    F.in = (const float* const __attribute__((address_space(4)))*)__builtin_amdgcn_kernarg_segment_ptr();
    F.out = args.out;
    F.Win_t = (bf16*)(ws + WS_WIN); F.Wout_t = (bf16*)(ws + WS_WOUT); F.Wcq_t = (bf16*)(ws + WS_WCQ); F.Wckv_t = (bf16*)(ws + WS_WCKV); F.Wco_t = (bf16*)(ws + WS_WCO);
    F.Wgu_t = (bf16*)(ws + WS_WGU); F.Wd_t = (bf16*)(ws + WS_WD);
    F.DT = (float*)(ws + WS_DT); F.SSQ1 = (float*)(ws + WS_SSQ1); F.SSQ2 = (float*)(ws + WS_SSQ2); F.SSQ3 = (float*)(ws + WS_SSQ3); F.YS = (float*)(ws + WS_YSS) - (size_t)MP * 512; F.ST = (float*)(ws + WS_R3); F.CD = (float*)(ws + WS_CD); F.HS = (bf16*)(ws + WS_HS);
    F.MN = (bf16*)(ws + WS_MN); F.MKVB = (bf16*)(ws + WS_MKVB); F.XN = (bf16*)(ws + WS_R1); F.MIX = (bf16*)(ws + WS_R1); F.PROJ = (bf16*)(ws + WS_R2); F.HM = (bf16*)(ws + WS_R2);
    F.XC = (bf16*)(ws + WS_XCS) - (size_t)MP * 1024; F.QC = (bf16*)(ws + WS_R3); F.OC = (bf16*)(ws + WS_R3 + 33 * MiB); F.HB = (bf16*)(ws + WS_HB);
    { int t0 = threadIdx.x; asm volatile("" : "+v"(t0));
      for (int u = t0; u < (LDS_BYTES - LDSCTL_OFF) / 4; u += NWAVES * 64) ((LAS unsigned*)(F.lds + LDSCTL_OFF))[u] = 0u; }
    __syncthreads();
    XcdBarrier bar; bar.bar = (unsigned*)(F.ctl + CW_BAR); bar.x = 0; bar.st = nullptr;
    if (N_LAUNCHES == 1) bar = xcd_barrier_post((unsigned*)(F.ctl + CW_BAR), F.MISC + 8);
#define GRID_BAR() do { if (N_LAUNCHES == 1) { xcd_barrier(bar); } } while (0)
    const int lo = args.ph_lo, hi = args.ph_hi;
#define IN(k) (lo <= (k) && (k) < hi)
#define SEAM(k) do { if (IN(k) && IN((k) + 1)) GRID_BAR(); } while (0)
    if (IN(0)) { p0_prologue(F); VM_WAIT(); __syncthreads(); } SEAM(0);
    if (IN(1)) {
        constexpr int nt1 = (MP / 256) * (NPROJ / 256);
        { pg8::Gemm g{F.XN, F.Win_t, MP, NPROJ, DM}; pg8::StaticOrder S; S.init(MP, NPROJ, F.G, (int)blockIdx.x); pg8::EpiBf16P E{F.PROJ, NPROJ};
          pg8::gemm_phase<pg8::EpiBf16P, pg8::StaticOrder, true, true>(F.lds + RING_OFF, g, S, E); }
        { pg8::Gemm g{F.MN, F.Wckv_t, NBATCH * NMEM, 1024, DM}; pg8::StaticOrder S;
          S.init(NBATCH * NMEM, 1024, F.G, (int)((blockIdx.x + F.G - (nt1 % F.G)) % F.G)); pg8::EpiMemKV E{F.out + O_PMEMK, F.out + O_PMEMV, F.MKVB};
          pg8::gemm_phase<pg8::EpiMemKV, pg8::StaticOrder, true, true>(F.lds + RING_OFF, g, S, E); }
        { SkBf16 E{F.PROJ, NPROJ}; skinny_gemm(F, F.XN, DM, F.Win_t, NPROJ / 64, E, (nt1 + 32) % 256); }
    } SEAM(1);
    if (IN(2)) { ssd_states(F); n1_conv(F); } SEAM(2);
    if (IN(3)) { ssd_scan(F); n2_ssd(F); } SEAM(3);
    if (IN(4)) { ssd_output(F); n3_gate(F); swa_phase(F); } SEAM(4);
    if (IN(5)) {
        { pg8::Gemm g{F.MIX, F.Wout_t, MP, DM, DM}; pg8::StaticOrder S; S.init(MP, DM, F.G, (int)blockIdx.x); pg8::EpiResidB<false> E{F.in[I_XP], F.HB, F.SSQ1};
          pg8::gemm_phase<pg8::EpiResidB<false>, pg8::StaticOrder, true, true>(F.lds + RING_OFF, g, S, E); }
        { SkResid<false> E{F.in[I_XS], (size_t)MP, F.HB, F.SSQ1}; skinny_gemm(F, F.MIX, DM, F.Wout_t, 16, E, 0); }
    } SEAM(5);
    if (IN(6)) {
        { pg8::Gemm g{F.HB, F.Wcq_t, MP, CA, DM}; pg8::StaticOrder S; S.init(MP, CA, F.G, (int)blockIdx.x); pg8::EpiScaleBf16 E{F.QC, CA, F.SSQ1, 0.08838834764831845f};
          pg8::gemm_phase<pg8::EpiScaleBf16, pg8::StaticOrder, true, true>(F.lds + RING_OFF, g, S, E); }
        { SkScale E{F.QC, CA, F.SSQ1, 0.08838834764831845f}; skinny_gemm(F, F.HB, DM, F.Wcq_t, 8, E, 0); }
    } SEAM(6);
    if (IN(7)) { cx_phase(F); } SEAM(7);
    if (IN(8)) {
        { pg8::Gemm g{F.OC, F.Wco_t, MP, DM, CA}; pg8::StaticOrder S; S.init(MP, DM, F.G, (int)blockIdx.x); pg8::EpiResidB<true> E{F.HB, F.HB, F.SSQ2};
          pg8::gemm_phase<pg8::EpiResidB<true>, pg8::StaticOrder, true, true>(F.lds + RING_OFF, g, S, E); }
        { SkResid<true> E{F.HB, (size_t)0, F.HB, F.SSQ2}; skinny_gemm(F, F.OC, CA, F.Wco_t, 16, E, 0); }
    } SEAM(8);
    if (IN(9)) {
        { pg8::Gemm g{F.HB, F.Wgu_t, MP, 2 * DFF, DM}; pg8::StaticOrder S; S.init(MP, 2 * DFF, F.G, (int)blockIdx.x); pg8::EpiSwiGLU E{F.HM, DFF, F.SSQ2};
          pg8::gemm_phase<pg8::EpiSwiGLU, pg8::StaticOrder, true, true>(F.lds + RING_OFF, g, S, E); }
        { SkSwiGLU E{F.HM, F.SSQ2}; skinny_gemm(F, F.HB, DM, F.Wgu_t, DFF / 32, E, 0); }
    } SEAM(9);
    if (IN(10)) {
        { pg8::Gemm g{F.HM, F.Wd_t, MP, DM, DFF}; pg8::StaticOrder S; S.init(MP, DM, F.G, (int)blockIdx.x); pg8::EpiResidB<true> E{F.HB, F.HB, F.SSQ3};
          pg8::gemm_phase<pg8::EpiResidB<true>, pg8::StaticOrder, true, true>(F.lds + RING_OFF, g, S, E); }
        { SkResid<true> E{F.HB, (size_t)0, F.HB, F.SSQ3}; skinny_gemm(F, F.HM, DFF, F.Wd_t, 16, E, 0); }
    } SEAM(10);
    if (IN(11)) { p11_final(F); }
#undef IN
#undef SEAM
}

extern "C" void kernel_launch(void* const* d_in, const int* in_sizes, int n_in, void* d_out, int out_size, void* d_ws, size_t ws_size, hipStream_t stream) {
    static int grid = 0;
    if (grid == 0) {
        if (n_in != 31 || out_size != (int)O_END || ws_size < WS_END) { fprintf(stderr, "kernel_launch: unexpected shapes: n_in %d out %d ws %zu\n", n_in, out_size, ws_size); grid = -1; return; }
        int dev = 0, cus = 0;
        if (hipGetDevice(&dev) != hipSuccess || hipDeviceGetAttribute(&cus, hipDeviceAttributeMultiprocessorCount, dev) != hipSuccess) { grid = -1; return; }
        if (hipFuncSetAttribute((const void*)skel_fwd, hipFuncAttributeMaxDynamicSharedMemorySize, LDS_BYTES) != hipSuccess) { fprintf(stderr, "kernel_launch: hipFuncSetAttribute failed\n"); grid = -1; return; }
        (void)hipGetLastError();
        grid = cus;
    }
    if (grid < 0) return;
    if (hipMemsetAsync((char*)d_ws + WS_CTL, 0, CTL_ZERO_BYTES, stream) != hipSuccess) { fprintf(stderr, "kernel_launch: memset failed\n"); return; }
    Args a{};
    for (int i = 0; i < 31; ++i) a.in[i] = (const float*)d_in[i];
    a.out = (float*)d_out; a.ws = (unsigned char*)d_ws;
    for (int li = 0; li < N_LAUNCHES; ++li) {
        a.ph_lo = (N_LAUNCHES == 1) ? 0 : li; a.ph_hi = (N_LAUNCHES == 1) ? NPH : li + 1; a.li = li;
        hipLaunchKernelGGL(skel_fwd, dim3(grid), dim3(NWAVES * 64), LDS_BYTES, stream, a);
        const hipError_t le = hipPeekAtLastError();
        if (le != hipSuccess) { fprintf(stderr, "kernel_launch: launch %d failed: %s\n", li, hipGetErrorName(le)); break; }
    }
}
```

```cpp
#include <hip/hip_runtime.h>
#include <cstdio>
#include <cstdint>
#include <cmath>
namespace pg8 {
#define PG8_LAS __attribute__((address_space(3)))
typedef unsigned short bf16_t;
typedef short bf16x8 __attribute__((ext_vector_type(8)));
typedef float f32x4 __attribute__((ext_vector_type(4)));
typedef unsigned u32x4 __attribute__((ext_vector_type(4)));
constexpr int BM = 256, BK = 64, HALF = 128, HTB = HALF * BK * 2  , STAGE_BYTES = 8 * HTB, NXCD = 8, WGM = 8;

__host__ __device__ __forceinline__ int lds_byte(int r, int c) { const int st = (r >> 4) * 2 + (c >> 5), rr = r & 15, cc = c & 31, ob = rr * 64 + cc * 2; return st * 1024 + (ob ^ (((ob >> 9) & 1) << 5)); }
__host__ __device__ __forceinline__ void stage_rc(int b, int& R, int& C) { const int st = b / 1024, sb = b % 1024, swz = sb ^ (((sb >> 9) & 1) << 5); R = (st >> 1) * 16 + swz / 64; C = (st & 1) * 32 + (swz % 64) / 2; }
__host__ __device__ __forceinline__ int perm32(int rho) { const int n = rho >> 4, i = rho & 15; return 8 * (i >> 2) + 4 * n + (i & 3); }

struct Unit { int pm, pn; };
struct Gemm { const bf16_t* A; const bf16_t* Bt; int M, N, K; };

struct StaticOrder {
    int nM, nN, nwg, G, c;
    __host__ __device__ void init(int M, int N, int G_, int c_) { nM = M / BM; nN = N / BM; nwg = nM * nN; G = G_; c = c_; }
    __host__ __device__ bool next(int i, Unit& u) const {
        const long L = (long)i * G + c; if (L >= nwg) return false;
        int wgid = (int)L; { const int q = nwg / NXCD, r = nwg % NXCD, xcd = wgid % NXCD, off = wgid / NXCD; wgid = (xcd < r ? xcd * (q + 1) : r * (q + 1) + (xcd - r) * q) + off; }
        const int nig = WGM * nN, gid = wgid / nig, fm = gid * WGM, gsz = (nM - fm) < WGM ? (nM - fm) : WGM;
        u.pm = fm + ((wgid % nig) % gsz); u.pn = (wgid % nig) / gsz; return true;
    }
    __device__ __forceinline__ void a_ready(const Unit&) const {}
    __device__ __forceinline__ void done(const Unit&) const {}
};

__device__ __forceinline__ unsigned cvt_pk_bf16(float lo, float hi) { unsigned r; asm volatile("v_cvt_pk_bf16_f32 %0, %1, %2" : "=v"(r) : "v"(lo), "v"(hi)); return r; }
typedef unsigned u32x2 __attribute__((ext_vector_type(2)));
constexpr float RMS_EPS = 1e-6f;
__device__ __forceinline__ float row_rstd(const float* ssq, int row, int fq) {
    const f32x4 p = *(const f32x4*)(ssq + (size_t)row * 16 + 4 * fq);
    float s = (p[0] + p[1]) + (p[2] + p[3]);
    s += __shfl_xor(s, 16); s += __shfl_xor(s, 32);
    return __builtin_amdgcn_rsqf(s * (1.0f / 1024.0f) + RMS_EPS);
}
__device__ __forceinline__ float silu_f(float x) { return x * __builtin_amdgcn_rcpf(1.0f + __expf(-x)); }

struct EpiBf16P {
    static constexpr bool PERM = true, AFTER_DRAIN = false;
    bf16_t* O; int ldc;
    __device__ __forceinline__ void operator()(const f32x4 (&acc)[2][2][4][2], const Unit& u, int wr, int wc, int fr, int fq) const {
        const int row0 = u.pm * BM + wr * 64 + fr, col0 = u.pn * BM + wc * 32 + 8 * fq;
#pragma unroll
        for (int ai = 0; ai < 2; ++ai)
#pragma unroll
            for (int m = 0; m < 4; ++m) { bf16_t* rowp = O + (size_t)(row0 + ai * HALF + m * 16) * ldc + col0;
#pragma unroll
                for (int bj = 0; bj < 2; ++bj) { const f32x4 v0 = acc[ai][bj][m][0], v1 = acc[ai][bj][m][1];
                    u32x4 w; w.x = cvt_pk_bf16(v0[0], v0[1]); w.y = cvt_pk_bf16(v0[2], v0[3]); w.z = cvt_pk_bf16(v1[0], v1[1]); w.w = cvt_pk_bf16(v1[2], v1[3]);
                    *(u32x4*)(rowp + bj * HALF) = w; } }
    }
};
struct EpiScaleBf16 {
    static constexpr bool PERM = true, AFTER_DRAIN = false;
    bf16_t* O; int ldc; const float* ssq; float scale;
    __device__ __forceinline__ void operator()(const f32x4 (&acc)[2][2][4][2], const Unit& u, int wr, int wc, int fr, int fq) const {
        const int row0 = u.pm * BM + wr * 64 + fr, col0 = u.pn * BM + wc * 32 + 8 * fq;
#pragma unroll
        for (int ai = 0; ai < 2; ++ai)
#pragma unroll
            for (int m = 0; m < 4; ++m) { const int row = row0 + ai * HALF + m * 16; const float r = row_rstd(ssq, row, fq) * scale; bf16_t* rowp = O + (size_t)row * ldc + col0;
#pragma unroll
                for (int bj = 0; bj < 2; ++bj) { const f32x4 v0 = acc[ai][bj][m][0] * r, v1 = acc[ai][bj][m][1] * r;
                    u32x4 w; w.x = cvt_pk_bf16(v0[0], v0[1]); w.y = cvt_pk_bf16(v0[2], v0[3]); w.z = cvt_pk_bf16(v1[0], v1[1]); w.w = cvt_pk_bf16(v1[2], v1[3]);
                    *(u32x4*)(rowp + bj * HALF) = w; } }
    }
};
struct EpiSwiGLU {
    static constexpr bool PERM = true, AFTER_DRAIN = false;
    bf16_t* O; int ldc; const float* ssq;
    __device__ __forceinline__ void operator()(const f32x4 (&acc)[2][2][4][2], const Unit& u, int wr, int wc, int fr, int fq) const {
        const int row0 = u.pm * BM + wr * 64 + fr, col0 = u.pn * HALF + wc * 32 + 8 * fq;
#pragma unroll
        for (int ai = 0; ai < 2; ++ai)
#pragma unroll
            for (int m = 0; m < 4; ++m) { const int row = row0 + ai * HALF + m * 16; const float r = row_rstd(ssq, row, fq);
                float h[8];
#pragma unroll
                for (int n = 0; n < 2; ++n)
#pragma unroll
                    for (int e = 0; e < 4; ++e) { const float g = acc[ai][0][m][n][e] * r, up = acc[ai][1][m][n][e] * r; h[4 * n + e] = silu_f(g) * up; }
                u32x4 w; w.x = cvt_pk_bf16(h[0], h[1]); w.y = cvt_pk_bf16(h[2], h[3]); w.z = cvt_pk_bf16(h[4], h[5]); w.w = cvt_pk_bf16(h[6], h[7]);
                *(u32x4*)(O + (size_t)row * ldc + col0) = w; }
    }
};
template <bool BASE_BF16> struct EpiResidB {
    static constexpr bool PERM = true, AFTER_DRAIN = false;
    const void* base; bf16_t* ob; float* ssq;
    __device__ __forceinline__ void operator()(const f32x4 (&acc)[2][2][4][2], const Unit& u, int wr, int wc, int fr, int fq) const {
        const int row0 = u.pm * BM + wr * 64 + fr, col0 = u.pn * BM + wc * 32 + 8 * fq;
#pragma unroll
        for (int ai = 0; ai < 2; ++ai)
#pragma unroll
            for (int m = 0; m < 4; ++m) { const int row = row0 + ai * HALF + m * 16; float ss = 0.f;
#pragma unroll
                for (int bj = 0; bj < 2; ++bj) { const size_t off = (size_t)row * 1024 + col0 + bj * HALF; f32x4 b0, b1;
                    if (BASE_BF16) { const u32x4 w = *(const u32x4*)((const bf16_t*)base + off);
                        b0 = (f32x4){__uint_as_float(w.x << 16), __uint_as_float(w.x & 0xffff0000u), __uint_as_float(w.y << 16), __uint_as_float(w.y & 0xffff0000u)};
                        b1 = (f32x4){__uint_as_float(w.z << 16), __uint_as_float(w.z & 0xffff0000u), __uint_as_float(w.w << 16), __uint_as_float(w.w & 0xffff0000u)}; }
                    else { b0 = *(const f32x4*)((const float*)base + off); b1 = *(const f32x4*)((const float*)base + off + 4); }
                    const f32x4 v0 = b0 + acc[ai][bj][m][0], v1 = b1 + acc[ai][bj][m][1];
                    ss += (v0[0] * v0[0] + v0[1] * v0[1]) + (v0[2] * v0[2] + v0[3] * v0[3]) + (v1[0] * v1[0] + v1[1] * v1[1]) + (v1[2] * v1[2] + v1[3] * v1[3]);
                    u32x4 w; w.x = cvt_pk_bf16(v0[0], v0[1]); w.y = cvt_pk_bf16(v0[2], v0[3]); w.z = cvt_pk_bf16(v1[0], v1[1]); w.w = cvt_pk_bf16(v1[2], v1[3]);
                    *(u32x4*)(ob + off) = w; }
                ss += __shfl_xor(ss, 16); ss += __shfl_xor(ss, 32);
                if (fq == 0) ssq[(size_t)row * 16 + u.pn * 4 + wc] = ss; }
    }
};
struct EpiMemKV {
    static constexpr bool PERM = false, AFTER_DRAIN = false;
    float* outk; float* outv; bf16_t* ob;
    __device__ __forceinline__ void operator()(const f32x4 (&acc)[2][2][4][2], const Unit& u, int wr, int wc, int fr, int fq) const {
        const int row0 = u.pm * BM + wr * 64 + fr, col0 = u.pn * BM + wc * 32 + 4 * fq;
#pragma unroll
        for (int ai = 0; ai < 2; ++ai)
#pragma unroll
            for (int m = 0; m < 4; ++m) { const int row = row0 + ai * HALF + m * 16;
#pragma unroll
                for (int bj = 0; bj < 2; ++bj)
#pragma unroll
                    for (int n = 0; n < 2; ++n) { const int c = col0 + bj * HALF + n * 16; const f32x4 v = acc[ai][bj][m][n];
                        float* o = (c < 512) ? outk + (size_t)row * 512 + c : outv + (size_t)row * 512 + (c - 512);
                        *(f32x4*)o = v; u32x2 w; w.x = cvt_pk_bf16(v[0], v[1]); w.y = cvt_pk_bf16(v[2], v[3]); *(u32x2*)(ob + (size_t)row * 1024 + c) = w; } }
    }
};
template <class Epi, class Sched, bool ALIGN_EPI = false, bool SP2 = false>
__device__ __forceinline__ void gemm_phase(PG8_LAS unsigned char* lds, const Gemm g, const Sched& S, const Epi& E) {
    const int tid = threadIdx.x, wid = __builtin_amdgcn_readfirstlane(tid >> 6), lane = tid & 63, wr = wid >> 2, wc = wid & 3, fr = lane & 15, fq = lane >> 4;
    const int K = g.K, nt = K / BK;
    unsigned voffA[2], voffB[2];
#pragma unroll
    for (int i = 0; i < 2; ++i) { int R, C; stage_rc(tid * 16 + i * 8192, R, C); const int Rb = Epi::PERM ? ((R & ~31) + perm32(R & 31)) : R;
        voffA[i] = (unsigned)(R * K + C) * 2u; voffB[i] = (unsigned)(Rb * K + C) * 2u; }
    const size_t kstep = (size_t)(BK * 2);
    const size_t hstep = (size_t)HALF * K * 2;
    const size_t tstep = 2 * hstep;
    const unsigned ldsw = (unsigned)wid * 1024u;
    const int aoff = lds_byte(wr * 64 + fr, fq * 8), boff = lds_byte(wc * 32 + fr, fq * 8);
#define PG8_SA(b, h) (((b) * 2 + (h)) * HTB)
#define PG8_SB(b, h) ((4 + (b) * 2 + (h)) * HTB)
#define PG8_STAGE(bufoff, gbase, voff) do { _Pragma("unroll") for (int _i = 0; _i < 2; ++_i) \
        __builtin_amdgcn_global_load_lds((const unsigned*)((const char*)(gbase) + (voff)[_i]), (PG8_LAS unsigned*)(lds + (bufoff) + ldsw + _i * 8192), 16, 0, 0); } while (0)
#define PG8_LDA(dst, b, h) do { _Pragma("unroll") for (int m = 0; m < 4; ++m) _Pragma("unroll") for (int k = 0; k < 2; ++k) dst[m][k] = *(const PG8_LAS bf16x8*)(lds + PG8_SA(b, h) + aoff + m * 2048 + k * 1024); } while (0)
#define PG8_LDB(dst, b, h) do { _Pragma("unroll") for (int n = 0; n < 2; ++n) _Pragma("unroll") for (int k = 0; k < 2; ++k) dst[n][k] = *(const PG8_LAS bf16x8*)(lds + PG8_SB(b, h) + boff + n * 2048 + k * 1024); } while (0)
#define PG8_MMA(ai, bj, At, Bt) do { __builtin_amdgcn_s_setprio(1); _Pragma("unroll") for (int m = 0; m < 4; ++m) _Pragma("unroll") for (int n = 0; n < 2; ++n) _Pragma("unroll") for (int k = 0; k < 2; ++k) \
        acc[ai][bj][m][n] = __builtin_amdgcn_mfma_f32_16x16x32_bf16(Bt[n][k], At[m][k], acc[ai][bj][m][n], 0, 0, 0); __builtin_amdgcn_s_setprio(0); } while (0)
#define PG8_WAIT_V(n) asm volatile("s_waitcnt vmcnt(" #n ")" ::: "memory")
#define PG8_WAIT_L(n) asm volatile("s_waitcnt lgkmcnt(" #n ")" ::: "memory")
#define PG8_BAR __builtin_amdgcn_s_barrier()
#define PG8_SCHED __builtin_amdgcn_sched_barrier(0)
    Unit cur, nxt; int ui = 0;
    if (!S.next(0, cur)) return;
    f32x4 acc[2][2][4][2];
#pragma unroll
    for (int a = 0; a < 2; ++a)
#pragma unroll
        for (int b = 0; b < 2; ++b)
#pragma unroll
            for (int m = 0; m < 4; ++m)
#pragma unroll
                for (int n = 0; n < 2; ++n) acc[a][b][m][n] = (f32x4){0.f, 0.f, 0.f, 0.f};
    bf16x8 At[4][2], B0[2][2], B1[2][2];
    const char* cA = (const char*)g.A + (size_t)cur.pm * tstep; const char* cB = (const char*)g.Bt + (size_t)cur.pn * tstep;
    S.a_ready(cur);
    if constexpr (SP2) {
        PG8_STAGE(PG8_SB(0, 0), cB, voffB); PG8_STAGE(PG8_SB(0, 1), cB + hstep, voffB); PG8_STAGE(PG8_SA(0, 0), cA, voffA); PG8_STAGE(PG8_SA(0, 1), cA + hstep, voffA);
        if (wr == 1) PG8_BAR;
        PG8_WAIT_V(2); PG8_BAR;
        PG8_STAGE(PG8_SB(1, 0), cB + kstep, voffB); PG8_STAGE(PG8_SA(1, 0), cA + kstep, voffA); PG8_STAGE(PG8_SB(1, 1), cB + hstep + kstep, voffB);
        PG8_WAIT_V(6); PG8_BAR;
    } else {
        PG8_STAGE(PG8_SB(0, 0), cB, voffB); PG8_STAGE(PG8_SA(0, 0), cA, voffA); PG8_STAGE(PG8_SB(0, 1), cB + hstep, voffB); PG8_STAGE(PG8_SA(0, 1), cA + hstep, voffA);
        if (wr == 1) PG8_BAR;
        PG8_WAIT_V(4); PG8_BAR;
        PG8_STAGE(PG8_SB(1, 0), cB + kstep, voffB); PG8_STAGE(PG8_SA(1, 0), cA + kstep, voffA); PG8_STAGE(PG8_SB(1, 1), cB + hstep + kstep, voffB);
        PG8_WAIT_V(6); PG8_BAR;
    }
    for (;;) {
        const bool has_next = S.next(ui + 1, nxt);
        const char* nA = has_next ? (const char*)g.A + (size_t)nxt.pm * tstep : cA; const char* nB = has_next ? (const char*)g.Bt + (size_t)nxt.pn * tstep : cB;
        for (int t = 0; t < nt; t += 2) {
            const bool last = (t == nt - 2);
            const char* a1 = cA + (size_t)(t + 1) * kstep;
            const char* a2 = last ? nA : cA + (size_t)(t + 2) * kstep; const char* b2 = last ? nB : cB + (size_t)(t + 2) * kstep;
            const char* a3 = a2 + kstep; const char* b3 = b2 + kstep;
            if (last && has_next) S.a_ready(nxt);
            if constexpr (SP2) {
            PG8_LDB(B0, 0, 0); PG8_LDB(B1, 0, 1); PG8_SCHED; PG8_LDA(At, 0, 0); PG8_STAGE(PG8_SA(1, 1), a1 + hstep, voffA);
            PG8_WAIT_V(8); PG8_WAIT_L(0); PG8_BAR; PG8_MMA(0, 0, At, B0); PG8_MMA(0, 1, At, B1); PG8_BAR; PG8_SCHED;
            PG8_LDA(At, 0, 1); PG8_STAGE(PG8_SB(0, 0), b2, voffB); PG8_STAGE(PG8_SB(0, 1), b2 + hstep, voffB); PG8_STAGE(PG8_SA(0, 0), a2, voffA);
            PG8_WAIT_V(8); PG8_WAIT_L(0); PG8_BAR; PG8_MMA(1, 0, At, B0); PG8_MMA(1, 1, At, B1); PG8_BAR; PG8_SCHED;
            PG8_LDB(B0, 1, 0); PG8_LDB(B1, 1, 1); PG8_SCHED; PG8_LDA(At, 1, 0); PG8_STAGE(PG8_SA(0, 1), a2 + hstep, voffA);
            PG8_WAIT_V(8); PG8_WAIT_L(0); PG8_BAR; PG8_MMA(0, 0, At, B0); PG8_MMA(0, 1, At, B1); PG8_BAR; PG8_SCHED;
            PG8_LDA(At, 1, 1); PG8_STAGE(PG8_SB(1, 0), b3, voffB); PG8_STAGE(PG8_SB(1, 1), b3 + hstep, voffB); PG8_STAGE(PG8_SA(1, 0), a3, voffA);
            PG8_WAIT_V(8); PG8_WAIT_L(0); PG8_BAR; PG8_MMA(1, 0, At, B0); PG8_MMA(1, 1, At, B1); PG8_BAR; PG8_SCHED;
            } else {
            PG8_LDB(B0, 0, 0); PG8_SCHED; PG8_LDA(At, 0, 0); PG8_STAGE(PG8_SA(1, 1), a1 + hstep, voffA);
            PG8_WAIT_L(8); PG8_BAR; PG8_WAIT_L(0); PG8_MMA(0, 0, At, B0); PG8_BAR; PG8_SCHED;
            PG8_LDB(B1, 0, 1); PG8_STAGE(PG8_SB(0, 0), b2, voffB);
            PG8_BAR; PG8_WAIT_L(0); PG8_MMA(0, 1, At, B1); PG8_BAR;
            PG8_LDA(At, 0, 1); PG8_STAGE(PG8_SA(0, 0), a2, voffA);
            PG8_BAR; PG8_WAIT_L(0); PG8_MMA(1, 0, At, B0); PG8_BAR; PG8_SCHED;
            PG8_STAGE(PG8_SB(0, 1), b2 + hstep, voffB);
            PG8_WAIT_V(6); PG8_BAR; PG8_MMA(1, 1, At, B1); PG8_BAR;
            PG8_LDB(B0, 1, 0); PG8_SCHED; PG8_LDA(At, 1, 0); PG8_STAGE(PG8_SA(0, 1), a2 + hstep, voffA);
            PG8_WAIT_L(8); PG8_BAR; PG8_WAIT_L(0); PG8_MMA(0, 0, At, B0); PG8_BAR; PG8_SCHED;
            PG8_LDB(B1, 1, 1); PG8_STAGE(PG8_SB(1, 0), b3, voffB);
            PG8_BAR; PG8_WAIT_L(0); PG8_MMA(0, 1, At, B1); PG8_BAR;
            PG8_LDA(At, 1, 1); PG8_STAGE(PG8_SA(1, 0), a3, voffA);
            PG8_BAR; PG8_WAIT_L(0); PG8_MMA(1, 0, At, B0); PG8_BAR; PG8_SCHED;
            PG8_STAGE(PG8_SB(1, 1), b3 + hstep, voffB);
            PG8_WAIT_V(6); PG8_BAR; PG8_MMA(1, 1, At, B1); PG8_BAR;
            }
        }
        if constexpr (ALIGN_EPI) { if (wr == 0) PG8_BAR; }
        if constexpr (!Epi::AFTER_DRAIN) { E(acc, cur, wr, wc, fr, fq); S.done(cur); }
        if (!has_next) break;
#pragma unroll
        for (int a = 0; a < 2; ++a)
#pragma unroll
            for (int b = 0; b < 2; ++b)
#pragma unroll
                for (int m = 0; m < 4; ++m)
#pragma unroll
                    for (int n = 0; n < 2; ++n) acc[a][b][m][n] = (f32x4){0.f, 0.f, 0.f, 0.f};
        cur = nxt; cA = nA; cB = nB; ++ui;
        if constexpr (ALIGN_EPI) { if (wr == 1) PG8_BAR; }
    }
    PG8_WAIT_V(0);
    if constexpr (!ALIGN_EPI) { if (wr == 0) PG8_BAR; }
    PG8_BAR;
    if constexpr (Epi::AFTER_DRAIN) { E.fused(acc, cur, wr, wc, fr, fq, lds, wid, lane); S.done(cur); }
#undef PG8_SA
#undef PG8_SB
#undef PG8_STAGE
#undef PG8_LDA
#undef PG8_LDB
#undef PG8_MMA
#undef PG8_WAIT_V
#undef PG8_WAIT_L
#undef PG8_BAR
#undef PG8_SCHED
}
}
#define GAS __attribute__((address_space(1)))
#define LAS __attribute__((address_space(3)))
typedef unsigned short bf16;
typedef unsigned v4u __attribute__((ext_vector_type(4)));
typedef float f32x4 __attribute__((ext_vector_type(4)));
typedef short bf16x8 __attribute__((ext_vector_type(8)));
typedef GAS unsigned gu32;
typedef GAS unsigned long long gu64;
#define RLX_AGENT __ATOMIC_RELAXED, __HIP_MEMORY_SCOPE_AGENT
#define LDS_WAIT() asm volatile("s_waitcnt lgkmcnt(0)" ::: "memory")
#define VM_WAIT() asm volatile("s_waitcnt vmcnt(0)" ::: "memory")
__device__ __forceinline__ unsigned long long rt() { return __builtin_amdgcn_s_memrealtime(); }
__device__ __forceinline__ unsigned f2bf(float f) { unsigned u = __builtin_bit_cast(unsigned, f); return (u + 0x7fffu + ((u >> 16) & 1u)) >> 16; }
__device__ __forceinline__ unsigned pk2(float lo, float hi) { return f2bf(lo) | (f2bf(hi) << 16); }

#define XB_TMO      128
#define XB_XCNT(j)  (256  + 64 * (j))
#define XB_XSUB(j)  (1280 + 64 * (j))
#define XB_XGEN(j)  (2304 + 64 * (j))
#define XB_TOP      3328
#define XB_TOPGEN   3392
#define XCD_BAR_WORDS 3456
#define XB_SPIN_CAP (1u << 18)

__device__ __forceinline__ unsigned xb_ld(unsigned* p)              { return __hip_atomic_load(p, __ATOMIC_RELAXED, __HIP_MEMORY_SCOPE_AGENT); }
__device__ __forceinline__ unsigned xb_add(unsigned* p, unsigned v) { return __hip_atomic_fetch_add(p, v, __ATOMIC_RELAXED, __HIP_MEMORY_SCOPE_AGENT); }
__device__ __forceinline__ unsigned xb_xcc_id() { return (unsigned)__builtin_amdgcn_s_getreg((3 << 11) | 20) & 0xFu; }
#define XB_SPIN(cond, bar) do { unsigned _sp = 0; while (cond) { __builtin_amdgcn_s_sleep(1); \
    if ((++_sp & 255u) == 0u) { if (xb_ld(&(bar)[XB_TMO])) break; if (_sp > XB_SPIN_CAP) { atomicAdd(&(bar)[XB_TMO], 1u); break; } } } } while (0)

struct XcdBarrier {
    unsigned* bar; unsigned x;
    volatile LAS unsigned* st;
};

__device__ __forceinline__ XcdBarrier xcd_barrier_post(unsigned* bar, volatile LAS unsigned* st) {
    XcdBarrier b; b.bar = bar; b.x = xb_xcc_id(); b.st = st;
    if (threadIdx.x == 0) (void)xb_add(&bar[XB_XCNT(b.x)], 1u);
    return b;
}
__device__ __forceinline__ void xcd_barrier_complete(unsigned* bar, unsigned x, unsigned& nloc, unsigned& nx) {
    const unsigned G = gridDim.x * gridDim.y * gridDim.z;
    unsigned sum, cnt, mine, sp = 0u;
    for (;;) {
        sum = 0u; cnt = 0u; mine = 0u;
#pragma unroll
        for (unsigned j = 0; j < 16; ++j) { const unsigned c = xb_ld(&bar[XB_XCNT(j)]); sum += c; cnt += (c > 0u) ? 1u : 0u; mine = (j == x) ? c : mine; }
        if (sum == G) break;
        __builtin_amdgcn_s_sleep(1);
        if ((++sp & 255u) == 0u) { if (xb_ld(&bar[XB_TMO])) break; if (sp > XB_SPIN_CAP) { atomicAdd(&bar[XB_TMO], 1u); break; } }
    }
    nloc = mine > 0u ? mine : 1u; nx = cnt > 0u ? cnt : 1u;
}

__device__ __forceinline__ void xcd_barrier(const XcdBarrier& b) {
    asm volatile("s_waitcnt vmcnt(0)" ::: "memory");
    __syncthreads();
    if (threadIdx.x == 0) {
        unsigned* bar = b.bar;
        __builtin_amdgcn_s_waitcnt(0);
        unsigned nloc = b.st[0], nx = b.st[1];
        if (nloc == 0u) { xcd_barrier_complete(bar, b.x, nloc, nx); b.st[0] = nloc; b.st[1] = nx; }
        const unsigned old = xb_add(&bar[XB_XSUB(b.x)], 1u);
        const unsigned gen = old / nloc;
        if (old + 1u == (gen + 1u) * nloc) {
            __builtin_amdgcn_fence(__ATOMIC_RELEASE, "agent");
            asm volatile("s_waitcnt vmcnt(0)" ::: "memory");
            const unsigned og = xb_add(&bar[XB_TOP], 1u);
            const unsigned tg = og / nx;
            if (og + 1u == (tg + 1u) * nx) xb_add(&bar[XB_TOPGEN], 1u);
            else XB_SPIN(xb_ld(&bar[XB_TOPGEN]) == tg, bar);
            __builtin_amdgcn_fence(__ATOMIC_ACQUIRE, "agent");
            xb_add(&bar[XB_XGEN(b.x)], 1u);
            asm volatile("s_waitcnt vmcnt(0)" ::: "memory");
        } else {
            XB_SPIN(xb_ld(&bar[XB_XGEN(b.x)]) == gen, bar);
            __builtin_amdgcn_fence(__ATOMIC_ACQUIRE, "agent");
            asm volatile("s_waitcnt vmcnt(0)" ::: "memory");
        }
    }
    __syncthreads();
}
constexpr int DM = 1024, NBATCH = 8, SEQ = 4096, MP = NBATCH * SEQ, NSS = 128, TS = 8, MS = NSS * TS, M = MP + MS;
constexpr int NPROJ = 2304, IN_DIM = 2312, DFF = 2816, NMEM = 256, CA = 512;
constexpr int PZ = 0, PXBC = 512, PQ = 1536, PK = 2048, PV = 2176;
constexpr float EPS = 1e-6f;
constexpr int NWAVES = 8;
constexpr size_t O_Y = 0, O_PCONV = 34603008, O_PSSM = 34627584, O_PSWAK = 35151872, O_PSWAV = 35282944, O_PMEMK = 35414016, O_PMEMV = 36462592,
                 O_SCONV = 37511168, O_SSSM = 37904384, O_SSWAK = 46292992, O_SSWAV = 48390144, O_END = 50487296;
constexpr size_t MiB = 1u << 20;
constexpr size_t WS_CTL = 0, CTL_ZERO_BYTES = 1 * MiB;
constexpr size_t WS_WIN = 2 * MiB, WS_WOUT = 7 * MiB, WS_WCQ = 9 * MiB, WS_WCKV = 10 * MiB, WS_WCO = 12 * MiB, WS_WGU = 13 * MiB, WS_WD = 24 * MiB;
constexpr size_t WS_DT = 30 * MiB, WS_SSQ1 = 32 * MiB, WS_SSQ2 = 35 * MiB, WS_SSQ3 = 38 * MiB, WS_MN = 41 * MiB, WS_MKVB = 45 * MiB;
constexpr size_t WS_R1 = 50 * MiB;
constexpr size_t WS_R2 = 116 * MiB;
constexpr size_t WS_R3 = 298 * MiB;
constexpr size_t WS_HS = 364 * MiB;
constexpr size_t WS_XCS = 396 * MiB, WS_YSS = 398 * MiB, WS_CD = 400 * MiB;
constexpr size_t WS_HB = 430 * MiB;
constexpr size_t WS_END = 496 * MiB;
constexpr int CW_BAR = 4096;
constexpr int RING_OFF = 0, RING_BYTES = 154624, LDSCTL_OFF = RING_BYTES, MISC_OFF = LDSCTL_OFF + 320, LDS_BYTES = 155648;

__device__ __forceinline__ float bf2f(unsigned short b) { return __uint_as_float((unsigned)b << 16); }
__device__ __forceinline__ float bflo(unsigned w) { return __uint_as_float(w << 16); }
__device__ __forceinline__ float bfhi(unsigned w) { return __uint_as_float(w & 0xffff0000u); }
__device__ __forceinline__ float wave_sum(float v) {
#pragma unroll
    for (int o = 1; o < 64; o <<= 1) v += __shfl_xor(v, o);
    return v;
}
__device__ __forceinline__ float wave_max(float v) {
#pragma unroll
    for (int o = 1; o < 64; o <<= 1) v = fmaxf(v, __shfl_xor(v, o));
    return v;
}
__device__ __forceinline__ float silu(float x) { return x / (1.0f + __expf(-x)); }
__device__ __forceinline__ float softplus(float x) { return fmaxf(x, 0.f) + log1pf(__expf(-fabsf(x))); }
__device__ __forceinline__ int t5_bucket(int n) { if (n < 16) return n; int l = 16 + (int)(logf((float)n * (1.0f / 16.0f)) / logf(8.0f) * 16.0f); return l < 31 ? l : 31; }

struct Frame {
    LAS unsigned char* lds;
    volatile LAS unsigned* MISC;
    gu32* ctl;
    int tid, lane, wave, vcu, G;
    const float* const __attribute__((address_space(4)))* in;
    float* out;
    bf16 *Win_t, *Wout_t, *Wcq_t, *Wckv_t, *Wco_t, *Wgu_t, *Wd_t;
    float *DT, *SSQ1, *SSQ2, *SSQ3, *YS, *ST, *CD, *SSQS1, *SSQS2, *SSQS3;
    bf16 *MN, *MKVB, *XN, *MIX, *PROJ, *HM, *XC, *QC, *OC, *HB, *HS;
};
enum { I_XP = 0, I_XS, I_MEMP, I_SCONV, I_SSSM, I_CSWAK, I_CSWAV, I_CMEMK, I_CMEMV, I_RELB, I_GMIX, I_WIN, I_CONVW, I_CONVB, I_DTB, I_ALOG, I_DSKIP, I_GSSD, I_SINKS, I_WOUT,
       I_GCROSS, I_GMEM, I_WCQ, I_WCK, I_WCV, I_WCO, I_GFFN, I_WGATE, I_WUP, I_WDOWN, I_GFINAL };

__device__ __forceinline__ void p0_transpose_item(const float* W, int ldw, int src_col0, int K, bf16* WT, int dst_row0, const float* gk, LAS float* scr, int kb, int lane) {
    const int k0 = 64 * kb;
#pragma unroll 8
    for (int i = 0; i < 32; ++i) { const int kk = 2 * i + (lane >> 5); float v = W[(size_t)(k0 + kk) * ldw + src_col0 + (lane & 31)]; if (gk) v *= gk[k0 + kk]; scr[kk * 33 + (lane & 31)] = v; }
    LDS_WAIT(); asm volatile("" ::: "memory");
    const int c = lane & 7;
#pragma unroll
    for (int j = 0; j < 4; ++j) { const int n = (lane >> 3) + 8 * j; const LAS float* s = scr + (8 * c) * 33 + n;
        v4u o; o.x = pk2(s[0 * 33], s[1 * 33]); o.y = pk2(s[2 * 33], s[3 * 33]); o.z = pk2(s[4 * 33], s[5 * 33]); o.w = pk2(s[6 * 33], s[7 * 33]);
        *(GAS v4u*)(WT + (size_t)(dst_row0 + n) * K + k0 + 8 * c) = o; }
    LDS_WAIT(); asm volatile("" ::: "memory");
}
__device__ __forceinline__ void p0_norm_row(const float* xrow, const float* g, bf16* orow, float* dtout, const LAS float* wdtT, int lane) {
    const GAS f32x4* xr = (const GAS f32x4*)xrow + lane; const GAS f32x4* gr = (const GAS f32x4*)g + lane;
    f32x4 v[4]; float s = 0.f;
#pragma unroll
    for (int j = 0; j < 4; ++j) { v[j] = xr[64 * j]; s += (v[j].x * v[j].x + v[j].y * v[j].y) + (v[j].z * v[j].z + v[j].w * v[j].w); }
    const float rstd = 1.0f / sqrtf(wave_sum(s) * (1.f / DM) + EPS);
#pragma unroll
    for (int j = 0; j < 4; ++j) v[j] = v[j] * rstd * gr[64 * j];
    GAS unsigned long long* o8 = (GAS unsigned long long*)orow + lane;
#pragma unroll
    for (int j = 0; j < 4; ++j) o8[64 * j] = (unsigned long long)pk2(v[j].x, v[j].y) | ((unsigned long long)pk2(v[j].z, v[j].w) << 32);
    if (dtout) {
        float a[8];
#pragma unroll
        for (int h = 0; h < 8; ++h) { float acc = 0.f;
#pragma unroll
            for (int j = 0; j < 4; ++j) { const f32x4 w = *(const LAS f32x4*)(wdtT + h * 1024 + 256 * j + 4 * lane); acc += (v[j].x * w.x + v[j].y * w.y) + (v[j].z * w.z + v[j].w * w.w); }
            a[h] = wave_sum(acc); }
        if (lane == 0) { *(f32x4*)(dtout) = (f32x4){a[0], a[1], a[2], a[3]}; *(f32x4*)(dtout + 4) = (f32x4){a[4], a[5], a[6], a[7]}; }
    }
}
__device__ __forceinline__ void p0_prologue(const Frame& F) {
    LAS float* wdtT = (LAS float*)(F.lds + RING_OFF);
    LAS float* scr = (LAS float*)(F.lds + RING_OFF + 32768 + F.wave * 12288);
    const float* w_in = F.in[I_WIN];
    for (int idx = F.tid; idx < 8192; idx += NWAVES * 64) { const int h = idx >> 10, k = idx & 1023; wdtT[idx] = w_in[(size_t)k * IN_DIM + 1536 + h]; }
    __syncthreads();
    const int gw = F.vcu * NWAVES + F.wave, NGW = F.G * NWAVES;
    constexpr int I1 = 72 * 16, I2 = 32 * 16, I3 = 16 * 16, I4 = 32 * 16, I5 = 32 * 8, I6 = 176 * 16, I7 = 32 * 44, NITEMS = I1 + I2 + I3 + I4 + I5 + I6 + I7;
    for (int it = gw; it < NITEMS; it += NGW) {
        int r = it;
        if (r < I1) { const int nb = r / 16, kb = r % 16, d0 = 32 * nb; p0_transpose_item(w_in, IN_DIM, d0 < 1536 ? d0 : d0 + 8, DM, F.Win_t, d0, nullptr, scr, kb, F.lane); continue; } r -= I1;
        if (r < I2) { const int nb = r / 16, kb = r % 16; p0_transpose_item(F.in[I_WOUT], DM, 32 * nb, DM, F.Wout_t, 32 * nb, nullptr, scr, kb, F.lane); continue; } r -= I2;
        if (r < I3) { const int nb = r / 16, kb = r % 16; p0_transpose_item(F.in[I_WCQ], CA, 32 * nb, DM, F.Wcq_t, 32 * nb, F.in[I_GCROSS], scr, kb, F.lane); continue; } r -= I3;
        if (r < I4) { const int nb = r / 16, kb = r % 16, d0 = 32 * nb; p0_transpose_item(d0 < 512 ? F.in[I_WCK] : F.in[I_WCV], CA, d0 & 511, DM, F.Wckv_t, d0, nullptr, scr, kb, F.lane); continue; } r -= I4;
        if (r < I5) { const int nb = r / 8, kb = r % 8; p0_transpose_item(F.in[I_WCO], DM, 32 * nb, CA, F.Wco_t, 32 * nb, nullptr, scr, kb, F.lane); continue; } r -= I5;
        if (r < I6) { const int nb = r / 16, kb = r % 16, d0 = 32 * nb, tile = d0 >> 8, within = d0 & 255;
            p0_transpose_item(within < 128 ? F.in[I_WGATE] : F.in[I_WUP], DFF, tile * 128 + (within & 127), DM, F.Wgu_t, d0, F.in[I_GFFN], scr, kb, F.lane); continue; } r -= I6;
        { const int nb = r / 44, kb = r % 44; p0_transpose_item(F.in[I_WDOWN], DM, 32 * nb, DFF, F.Wd_t, 32 * nb, nullptr, scr, kb, F.lane); }
    }
    for (int m = gw; m < M; m += NGW) {
        const float* xrow = m < MP ? F.in[I_XP] + (size_t)m * DM : F.in[I_XS] + (size_t)(m - MP) * DM;
        p0_norm_row(xrow, F.in[I_GMIX], F.XN + (size_t)m * DM, F.DT + (size_t)m * 8, wdtT, F.lane);
    }
    for (int m = gw; m < NBATCH * NMEM; m += NGW) p0_norm_row(F.in[I_MEMP] + (size_t)m * DM, F.in[I_GMEM], F.MN + (size_t)m * DM, nullptr, wdtT, F.lane);
}

__device__ __forceinline__ void n1_conv(const Frame& F) {
    const int gw = F.vcu * NWAVES + F.wave, NGW = F.G * NWAVES, lane = F.lane;
    const float* cw = F.in[I_CONVW]; const float* cb = F.in[I_CONVB];
    for (int m = MP + gw; m < M; m += NGW) {
        const bool samp = m >= MP; int t, L, seq;
        if (!samp) { seq = m / SEQ; t = m % SEQ; L = SEQ; } else { const int r = m - MP; seq = r / TS; t = r % TS; L = TS; }
        const float* hist = F.in[I_SCONV] + (size_t)seq * 3 * 1024;
#pragma unroll
        for (int j2 = 0; j2 < 2; ++j2) {
            const int c = 8 * lane + 512 * j2;
            float acc[8];
            { const f32x4 b0 = *(const f32x4*)(cb + c), b1 = *(const f32x4*)(cb + c + 4); acc[0] = b0.x; acc[1] = b0.y; acc[2] = b0.z; acc[3] = b0.w; acc[4] = b1.x; acc[5] = b1.y; acc[6] = b1.z; acc[7] = b1.w; }
            v4u raw_last = (v4u){0u, 0u, 0u, 0u};
#pragma unroll
            for (int k = 0; k < 4; ++k) {
                const int tt = t - 3 + k; float xv[8];
                if (tt >= 0) { const v4u raw = *(const v4u*)(F.PROJ + (size_t)(m - 3 + k) * NPROJ + PXBC + c);
                    xv[0] = bflo(raw.x); xv[1] = bfhi(raw.x); xv[2] = bflo(raw.y); xv[3] = bfhi(raw.y); xv[4] = bflo(raw.z); xv[5] = bfhi(raw.z); xv[6] = bflo(raw.w); xv[7] = bfhi(raw.w);
                    if (k == 3) raw_last = raw; }
                else if (samp) { const f32x4 h0 = *(const f32x4*)(hist + (size_t)(tt + 3) * 1024 + c), h1 = *(const f32x4*)(hist + (size_t)(tt + 3) * 1024 + c + 4);
                    xv[0] = h0.x; xv[1] = h0.y; xv[2] = h0.z; xv[3] = h0.w; xv[4] = h1.x; xv[5] = h1.y; xv[6] = h1.z; xv[7] = h1.w; }
                else {
#pragma unroll
                    for (int e = 0; e < 8; ++e) xv[e] = 0.f; }
                const f32x4 w0 = *(const f32x4*)(cw + k * 1024 + c), w1 = *(const f32x4*)(cw + k * 1024 + c + 4);
                acc[0] += xv[0] * w0.x; acc[1] += xv[1] * w0.y; acc[2] += xv[2] * w0.z; acc[3] += xv[3] * w0.w; acc[4] += xv[4] * w1.x; acc[5] += xv[5] * w1.y; acc[6] += xv[6] * w1.z; acc[7] += xv[7] * w1.w;
            }
#pragma unroll
            for (int e = 0; e < 8; ++e) acc[e] = silu(acc[e]);
            v4u o; o.x = pk2(acc[0], acc[1]); o.y = pk2(acc[2], acc[3]); o.z = pk2(acc[4], acc[5]); o.w = pk2(acc[6], acc[7]);
            *(v4u*)(F.XC + (size_t)m * 1024 + c) = o;
            if (t >= L - 3) {
                const int j = t - (L - 3);
                float* dst = F.out + (samp ? O_SCONV : O_PCONV) + ((size_t)seq * 3 + j) * 1024 + c;
                *(f32x4*)dst = (f32x4){bflo(raw_last.x), bfhi(raw_last.x), bflo(raw_last.y), bfhi(raw_last.y)};
                *(f32x4*)(dst + 4) = (f32x4){bflo(raw_last.z), bfhi(raw_last.z), bflo(raw_last.w), bfhi(raw_last.w)};
            }
        }
    }
    for (int it = gw; it < NBATCH * 3; it += NGW) {
        const int b = it / 3, j = it % 3; const bf16* src = F.PROJ + (size_t)(b * SEQ + SEQ - 3 + j) * NPROJ + PXBC; float* dst = F.out + O_PCONV + (size_t)it * 1024;
        for (int c = lane; c < 1024; c += 64) dst[c] = bf2f(src[c]);
    }
    for (int it = gw; it < NBATCH * 128 + NSS * 128; it += NGW) {
        const int c = 2 * lane;
        if (it < NBATCH * 128) { const int b = it >> 7, j = it & 127; const size_t src = (size_t)(b * SEQ + SEQ - 128 + j) * NPROJ;
            const unsigned kw = *(const unsigned*)(F.PROJ + src + PK + c), vw = *(const unsigned*)(F.PROJ + src + PV + c);
            float* ok = F.out + O_PSWAK + (size_t)it * 128 + c; float* ov = F.out + O_PSWAV + (size_t)it * 128 + c;
            ok[0] = bflo(kw); ok[1] = bfhi(kw); ov[0] = bflo(vw); ov[1] = bfhi(vw); }
        else { const int r = it - NBATCH * 128, s = r >> 7, j = r & 127; float* ok = F.out + O_SSWAK + (size_t)r * 128 + c; float* ov = F.out + O_SSWAV + (size_t)r * 128 + c;
            if (j < 120) { const size_t src = ((size_t)s * 128 + j + 8) * 128 + c; ok[0] = F.in[I_CSWAK][src]; ok[1] = F.in[I_CSWAK][src + 1]; ov[0] = F.in[I_CSWAV][src]; ov[1] = F.in[I_CSWAV][src + 1]; }
            else { const size_t src = (size_t)(MP + s * TS + j - 120) * NPROJ; const unsigned kw = *(const unsigned*)(F.PROJ + src + PK + c), vw = *(const unsigned*)(F.PROJ + src + PV + c);
                ok[0] = bflo(kw); ok[1] = bfhi(kw); ov[0] = bflo(vw); ov[1] = bfhi(vw); } }
    }
}

struct SsdStep { v4u b0, b1, c0, c1; float dtr; unsigned short xr; };
__device__ __forceinline__ void n2_load(SsdStep& s, const bf16* XC, const float* DT, size_t m, int h, int p, int g, int nq) {
    const bf16* row = XC + m * 1024;
    s.b0 = *(const v4u*)(row + 512 + g * 128 + nq * 16); s.b1 = *(const v4u*)(row + 512 + g * 128 + nq * 16 + 8);
    s.c0 = *(const v4u*)(row + 768 + g * 128 + nq * 16); s.c1 = *(const v4u*)(row + 768 + g * 128 + nq * 16 + 8);
    s.dtr = DT[m * 8 + h]; s.xr = row[h * 64 + p];
}
__device__ __forceinline__ void n2_step(const SsdStep& s, float (&st)[16], float A, float dtb, float dsk, float* YS, size_t m, int h, int p, int nq) {
    const float xv = bf2f(s.xr), dt = softplus(s.dtr + dtb), dA = __expf(dt * A), dx = dt * xv;
    const unsigned bw[8] = {s.b0.x, s.b0.y, s.b0.z, s.b0.w, s.b1.x, s.b1.y, s.b1.z, s.b1.w};
    const unsigned cw[8] = {s.c0.x, s.c0.y, s.c0.z, s.c0.w, s.c1.x, s.c1.y, s.c1.z, s.c1.w};
    float y = 0.f;
#pragma unroll
    for (int i = 0; i < 8; ++i) {
        st[2 * i] = dA * st[2 * i] + dx * bflo(bw[i]); st[2 * i + 1] = dA * st[2 * i + 1] + dx * bfhi(bw[i]);
        y += st[2 * i] * bflo(cw[i]) + st[2 * i + 1] * bfhi(cw[i]);
    }
    y += __shfl_xor(y, 1); y += __shfl_xor(y, 2); y += __shfl_xor(y, 4);
    if (nq == 0) YS[m * 512 + h * 64 + p] = y + dsk * xv;
}
__device__ __forceinline__ void n2_ssd(const Frame& F) {
    const int gw = F.vcu * NWAVES + F.wave, NGW = F.G * NWAVES, lane = F.lane;
    const int NIT = (NBATCH + NSS) * 64;
    for (int it = NBATCH * 64 + gw; it < NIT; it += NGW) {
        const int seq = it >> 6, h = (it >> 3) & 7, pg = it & 7, pl = lane >> 3, nq = lane & 7, p = pg * 8 + pl, g = h >> 2;
        const bool samp = seq >= NBATCH; const int T = samp ? TS : SEQ; const size_t m0 = samp ? (size_t)MP + (size_t)(seq - NBATCH) * TS : (size_t)seq * SEQ;
        float st[16];
        if (samp) { const float* s0 = F.in[I_SSSM] + (((size_t)(seq - NBATCH) * 8 + h) * 64 + p) * 128 + nq * 16;
#pragma unroll
            for (int i = 0; i < 4; ++i) { const f32x4 v = *(const f32x4*)(s0 + 4 * i); st[4 * i] = v.x; st[4 * i + 1] = v.y; st[4 * i + 2] = v.z; st[4 * i + 3] = v.w; } }
        else {
#pragma unroll
            for (int i = 0; i < 16; ++i) st[i] = 0.f; }
        const float A = -__expf(F.in[I_ALOG][h]), dtb = F.in[I_DTB][h], dsk = F.in[I_DSKIP][h];
        SsdStep c0, c1, c2, c3, n0, n1, n2, n3;
        n2_load(c0, F.XC, F.DT, m0 + 0, h, p, g, nq); n2_load(c1, F.XC, F.DT, m0 + 1, h, p, g, nq); n2_load(c2, F.XC, F.DT, m0 + 2, h, p, g, nq); n2_load(c3, F.XC, F.DT, m0 + 3, h, p, g, nq);
        for (int t = 0; t < T; t += 4) {
            const size_t m = m0 + t; const size_t mn = (t + 4 < T) ? m + 4 : m;
            n2_load(n0, F.XC, F.DT, mn + 0, h, p, g, nq); n2_load(n1, F.XC, F.DT, mn + 1, h, p, g, nq); n2_load(n2, F.XC, F.DT, mn + 2, h, p, g, nq); n2_load(n3, F.XC, F.DT, mn + 3, h, p, g, nq);
            n2_step(c0, st, A, dtb, dsk, F.YS, m + 0, h, p, nq); n2_step(c1, st, A, dtb, dsk, F.YS, m + 1, h, p, nq);
            n2_step(c2, st, A, dtb, dsk, F.YS, m + 2, h, p, nq); n2_step(c3, st, A, dtb, dsk, F.YS, m + 3, h, p, nq);
            c0 = n0; c1 = n1; c2 = n2; c3 = n3;
        }
        float* so = F.out + (samp ? O_SSSM + (((size_t)(seq - NBATCH) * 8 + h) * 64 + p) * 128 : O_PSSM + (((size_t)seq * 8 + h) * 64 + p) * 128) + nq * 16;
#pragma unroll
        for (int i = 0; i < 4; ++i) *(f32x4*)(so + 4 * i) = (f32x4){st[4 * i], st[4 * i + 1], st[4 * i + 2], st[4 * i + 3]};
    }
}

__device__ __forceinline__ void n3_gate(const Frame& F) {
    const int gw = F.vcu * NWAVES + F.wave, NGW = F.G * NWAVES, lane = F.lane, c = 8 * lane;
    const float* gn = F.in[I_GSSD];
    for (int m = MP + gw; m < M; m += NGW) {
        const f32x4 y0 = *(const f32x4*)(F.YS + (size_t)m * 512 + c), y1 = *(const f32x4*)(F.YS + (size_t)m * 512 + c + 4);
        const v4u zr = *(const v4u*)(F.PROJ + (size_t)m * NPROJ + PZ + c);
        float v[8] = {y0.x, y0.y, y0.z, y0.w, y1.x, y1.y, y1.z, y1.w};
        const float z[8] = {bflo(zr.x), bfhi(zr.x), bflo(zr.y), bfhi(zr.y), bflo(zr.z), bfhi(zr.z), bflo(zr.w), bfhi(zr.w)};
        float ss = 0.f;
#pragma unroll
        for (int e = 0; e < 8; ++e) { v[e] = v[e] * silu(z[e]); ss += v[e] * v[e]; }
#pragma unroll
        for (int o = 1; o < 32; o <<= 1) ss += __shfl_xor(ss, o);
        const float rs = 1.0f / sqrtf(ss * (1.0f / 256.0f) + EPS);
        const f32x4 g0 = *(const f32x4*)(gn + c), g1 = *(const f32x4*)(gn + c + 4);
        v4u o; o.x = pk2(v[0] * rs * g0.x, v[1] * rs * g0.y); o.y = pk2(v[2] * rs * g0.z, v[3] * rs * g0.w); o.z = pk2(v[4] * rs * g1.x, v[5] * rs * g1.y); o.w = pk2(v[6] * rs * g1.z, v[7] * rs * g1.w);
        *(v4u*)(F.MIX + (size_t)m * 1024 + c) = o;
    }
}

__device__ __forceinline__ void n4_swa(const Frame& F) {
    const int gw = F.vcu * NWAVES + F.wave, NGW = F.G * NWAVES, lane = F.lane;
    const float* relb = F.in[I_RELB]; const float* sinks = F.in[I_SINKS];
    for (int it = gw; it < M * 8; it += NGW) {
        const int m = it >> 3, head = it & 7, kv = head >> 2;
        const bool samp = m >= MP; int t, seq;
        if (!samp) { seq = m / SEQ; t = m % SEQ; } else { const int r = m - MP; seq = r / TS; t = r % TS; }
        v4u q[8];
#pragma unroll
        for (int i = 0; i < 8; ++i) q[i] = *(const v4u*)(F.PROJ + (size_t)m * NPROJ + PQ + head * 64 + 8 * i);
        float sc[2];
#pragma unroll
        for (int hh = 0; hh < 2; ++hh) {
            const int dist = lane + 64 * hh, tk = t - dist; float dot = 0.f; bool valid = true;
            if (tk >= 0) { const bf16* kr = F.PROJ + (size_t)(m - dist) * NPROJ + PK + kv * 64;
#pragma unroll
                for (int i = 0; i < 8; ++i) { const v4u k8 = *(const v4u*)(kr + 8 * i);
                    dot += bflo(q[i].x) * bflo(k8.x) + bfhi(q[i].x) * bfhi(k8.x) + bflo(q[i].y) * bflo(k8.y) + bfhi(q[i].y) * bfhi(k8.y)
                         + bflo(q[i].z) * bflo(k8.z) + bfhi(q[i].z) * bfhi(k8.z) + bflo(q[i].w) * bflo(k8.w) + bfhi(q[i].w) * bfhi(k8.w); } }
            else if (samp) { const float* kr = F.in[I_CSWAK] + (((size_t)seq * 128 + (128 + tk)) * 2 + kv) * 64;
#pragma unroll
                for (int i = 0; i < 8; ++i) { const f32x4 k0 = *(const f32x4*)(kr + 8 * i), k1 = *(const f32x4*)(kr + 8 * i + 4);
                    dot += bflo(q[i].x) * k0.x + bfhi(q[i].x) * k0.y + bflo(q[i].y) * k0.z + bfhi(q[i].y) * k0.w + bflo(q[i].z) * k1.x + bfhi(q[i].z) * k1.y + bflo(q[i].w) * k1.z + bfhi(q[i].w) * k1.w; } }
            else valid = false;
            sc[hh] = valid ? dot * 0.125f + relb[t5_bucket(dist) * 8 + head] : -INFINITY;
        }
        const float sk = sinks[head];
        const float mx = fmaxf(wave_max(fmaxf(sc[0], sc[1])), sk);
        const float p0 = __expf(sc[0] - mx), p1 = __expf(sc[1] - mx);
        const float den = wave_sum(p0 + p1) + __expf(sk - mx);
        float acc = 0.f;
        const int nd = samp ? 128 : (t + 1 < 128 ? t + 1 : 128);
        for (int dist = 0; dist < nd; ++dist) {
            const float p = __shfl(dist < 64 ? p0 : p1, dist & 63); const int tk = t - dist; float v;
            if (tk >= 0) v = bf2f(F.PROJ[(size_t)(m - dist) * NPROJ + PV + kv * 64 + lane]);
            else v = F.in[I_CSWAV][(((size_t)seq * 128 + (128 + tk)) * 2 + kv) * 64 + lane];
            acc += p * v;
        }
        F.MIX[(size_t)m * 1024 + 512 + head * 64 + lane] = (bf16)f2bf(acc / den);
    }
}

__device__ __forceinline__ void n5_cross(const Frame& F) {
    const int gw = F.vcu * NWAVES + F.wave, NGW = F.G * NWAVES, lane = F.lane;
    LAS unsigned* qs = (LAS unsigned*)(F.lds + RING_OFF + F.wave * 2048);
    LAS float* ps = (LAS float*)(F.lds + RING_OFF + F.wave * 2048 + 256);
    for (int it = gw; it < M * 4; it += NGW) {
        const int m = it >> 2, head = it & 3; const bool samp = m >= MP; const int seq = samp ? (m - MP) / TS : m / SEQ;
        qs[lane] = *(const unsigned*)(F.QC + (size_t)m * CA + head * 128 + 2 * lane);
        LDS_WAIT(); asm volatile("" ::: "memory");
        float sc[4];
#pragma unroll
        for (int i = 0; i < 4; ++i) { const int j = lane + 64 * i; float dot = 0.f;
            if (!samp) { const bf16* kr = F.MKVB + (size_t)(seq * NMEM + j) * 1024 + head * 128;
#pragma unroll
                for (int c8 = 0; c8 < 16; ++c8) { const v4u q8 = *(const LAS v4u*)(qs + 4 * c8); const v4u k8 = *(const v4u*)(kr + 8 * c8);
                    dot += bflo(q8.x) * bflo(k8.x) + bfhi(q8.x) * bfhi(k8.x) + bflo(q8.y) * bflo(k8.y) + bfhi(q8.y) * bfhi(k8.y)
                         + bflo(q8.z) * bflo(k8.z) + bfhi(q8.z) * bfhi(k8.z) + bflo(q8.w) * bflo(k8.w) + bfhi(q8.w) * bfhi(k8.w); } }
            else { const float* kr = F.in[I_CMEMK] + (((size_t)seq * NMEM + j) * 4 + head) * 128;
#pragma unroll
                for (int c8 = 0; c8 < 16; ++c8) { const v4u q8 = *(const LAS v4u*)(qs + 4 * c8); const f32x4 k0 = *(const f32x4*)(kr + 8 * c8), k1 = *(const f32x4*)(kr + 8 * c8 + 4);
                    dot += bflo(q8.x) * k0.x + bfhi(q8.x) * k0.y + bflo(q8.y) * k0.z + bfhi(q8.y) * k0.w + bflo(q8.z) * k1.x + bfhi(q8.z) * k1.y + bflo(q8.w) * k1.z + bfhi(q8.w) * k1.w; } }
            sc[i] = dot; }
        const float mx = wave_max(fmaxf(fmaxf(sc[0], sc[1]), fmaxf(sc[2], sc[3])));
        float psum = 0.f;
#pragma unroll
        for (int i = 0; i < 4; ++i) { const float p = __expf(sc[i] - mx); ps[lane + 64 * i] = p; psum += p; }
        const float den = wave_sum(psum);
        LDS_WAIT(); asm volatile("" ::: "memory");
        float a0 = 0.f, a1 = 0.f;
        if (!samp) { const bf16* vr = F.MKVB + (size_t)(seq * NMEM) * 1024 + 512 + head * 128 + 2 * lane;
#pragma unroll 8
            for (int j = 0; j < NMEM; ++j) { const float p = ps[j]; const unsigned w = *(const unsigned*)(vr + (size_t)j * 1024); a0 += p * bflo(w); a1 += p * bfhi(w); } }
        else { const float* vr = F.in[I_CMEMV] + ((size_t)seq * NMEM * 4 + head) * 128 + 2 * lane;
#pragma unroll 8
            for (int j = 0; j < NMEM; ++j) { const float p = ps[j]; const float v0 = vr[(size_t)j * 512], v1 = vr[(size_t)j * 512 + 1]; a0 += p * v0; a1 += p * v1; } }
        const float inv = 1.0f / den;
        *(unsigned*)(F.OC + (size_t)m * CA + head * 128 + 2 * lane) = pk2(a0 * inv, a1 * inv);
        LDS_WAIT(); asm volatile("" ::: "memory");
    }
}

__device__ __forceinline__ void p11_final(const Frame& F) {
    const int gw = F.vcu * NWAVES + F.wave, NGW = F.G * NWAVES, lane = F.lane;
    const f32x4 g0 = *(const f32x4*)(F.in[I_GFINAL] + 8 * lane), g1 = *(const f32x4*)(F.in[I_GFINAL] + 8 * lane + 4), g2 = *(const f32x4*)(F.in[I_GFINAL] + 512 + 8 * lane), g3 = *(const f32x4*)(F.in[I_GFINAL] + 512 + 8 * lane + 4);
    for (int m = gw; m < M; m += NGW) {
        const v4u a = *(const v4u*)(F.HB + (size_t)m * DM + 8 * lane), b = *(const v4u*)(F.HB + (size_t)m * DM + 512 + 8 * lane);
        f32x4 v0 = (f32x4){bflo(a.x), bfhi(a.x), bflo(a.y), bfhi(a.y)}, v1 = (f32x4){bflo(a.z), bfhi(a.z), bflo(a.w), bfhi(a.w)};
        f32x4 v2 = (f32x4){bflo(b.x), bfhi(b.x), bflo(b.y), bfhi(b.y)}, v3 = (f32x4){bflo(b.z), bfhi(b.z), bflo(b.w), bfhi(b.w)};
        float s = 0.f;
#pragma unroll
        for (int e = 0; e < 4; ++e) s += (v0[e] * v0[e] + v1[e] * v1[e]) + (v2[e] * v2[e] + v3[e] * v3[e]);
        const float rstd = 1.0f / sqrtf(wave_sum(s) * (1.f / DM) + EPS);
        float* o = F.out + O_Y + (size_t)m * DM + 8 * lane;
        *(f32x4*)(o) = v0 * rstd * g0; *(f32x4*)(o + 4) = v1 * rstd * g1; *(f32x4*)(o + 512) = v2 * rstd * g2; *(f32x4*)(o + 516) = v3 * rstd * g3;
    }
}

typedef short s16x4 __attribute__((ext_vector_type(4)));
typedef unsigned u32x2 __attribute__((ext_vector_type(2)));
#define MFMA16(a, b, c) __builtin_amdgcn_mfma_f32_16x16x32_bf16((a), (b), (c), 0, 0, 0)
__device__ __forceinline__ bf16x8 cat8(s16x4 lo, s16x4 hi) { return __builtin_shufflevector(lo, hi, 0, 1, 2, 3, 4, 5, 6, 7); }
__device__ __forceinline__ bf16x8 pack_p(const f32x4& a, const f32x4& b) {
    v4u w; w.x = pk2(a[0], a[1]); w.y = pk2(a[2], a[3]); w.z = pk2(b[0], b[1]); w.w = pk2(b[2], b[3]); return __builtin_bit_cast(bf16x8, w);
}

constexpr int SW_KSTR = 144, SW_VSTR = 528;
constexpr int SW_K = 0, SW_V = 256 * SW_KSTR, SW_BIAS = SW_V + 64 * SW_VSTR, SW_END = SW_BIAS + 8 * 128 * 4;
__device__ __forceinline__ void swa_item(const LAS unsigned char* lds, const float* sinks, int kt0, int jmin, int tmax, const bf16* qptr, int qpos, int head, bf16* optr, int lane) {
    const int ar = lane & 15, jj = lane >> 4;
    const LAS unsigned char* Kl = lds + SW_K; const LAS unsigned char* Vl = lds + SW_V; const LAS float* biasT = (const LAS float*)(lds + SW_BIAS);
    bf16x8 qf[2];
#pragma unroll
    for (int ks = 0; ks < 2; ++ks) qf[ks] = *(const bf16x8*)(qptr + 32 * ks + 8 * jj);
    f32x4 sacc[10]; sacc[9] = (f32x4){0.f, 0.f, 0.f, 0.f};
#pragma unroll
    for (int kt = 0; kt < 9; ++kt) { sacc[kt] = (f32x4){0.f, 0.f, 0.f, 0.f};
#pragma unroll
        for (int ks = 0; ks < 2; ++ks) { const bf16x8 a = *(const LAS bf16x8*)(Kl + (16 * (kt0 + kt) + ar) * SW_KSTR + 64 * ks + 16 * jj); sacc[kt] = MFMA16(a, qf[ks], sacc[kt]); }
        if (kt & 1) __builtin_amdgcn_sched_barrier(0); }
    float mx = -INFINITY;
#pragma unroll
    for (int kt = 0; kt < 9; ++kt)
#pragma unroll
        for (int r = 0; r < 4; ++r) { const int j = 16 * (kt0 + kt) + 4 * jj + r, dist = 128 + qpos - j; const bool valid = (dist >= 0) && (dist < 128) && (j >= jmin);
            const float s = valid ? sacc[kt][r] * 0.125f + biasT[head * 128 + (dist & 127)] : -INFINITY; sacc[kt][r] = s; mx = fmaxf(mx, s); }
    mx = fmaxf(mx, __shfl_xor(mx, 16)); mx = fmaxf(mx, __shfl_xor(mx, 32));
    const float sk = sinks[head]; mx = fmaxf(mx, sk);
    float sum = 0.f;
#pragma unroll
    for (int kt = 0; kt < 9; ++kt)
#pragma unroll
        for (int r = 0; r < 4; ++r) { const float p = __expf(sacc[kt][r] - mx); sacc[kt][r] = p; sum += p; }
    sum += __shfl_xor(sum, 16); sum += __shfl_xor(sum, 32);
    const float inv = 1.0f / (sum + __expf(sk - mx));
    f32x4 oacc[4];
#pragma unroll
    for (int dt = 0; dt < 4; ++dt) oacc[dt] = (f32x4){0.f, 0.f, 0.f, 0.f};
#pragma unroll
    for (int u = 0; u < 5; ++u) {
        const bf16x8 pb = pack_p(sacc[2 * u], sacc[2 * u + 1]);
        const int T0 = kt0 + 2 * u, T1r = kt0 + 2 * u + 1, T1 = T1r < tmax ? T1r : tmax;
#pragma unroll
        for (int dt = 0; dt < 4; ++dt) {
            const LAS unsigned char* vrow = Vl + (16 * dt + ar) * SW_VSTR + 8 * jj;
            const s16x4 lo = *(const LAS s16x4*)(vrow + 32 * T0), hi = *(const LAS s16x4*)(vrow + 32 * T1);
            oacc[dt] = MFMA16(cat8(lo, hi), pb, oacc[dt]);
        }
        __builtin_amdgcn_sched_barrier(0);
    }
#pragma unroll
    for (int dt = 0; dt < 4; ++dt) { u32x2 w; w.x = pk2(oacc[dt][0] * inv, oacc[dt][1] * inv); w.y = pk2(oacc[dt][2] * inv, oacc[dt][3] * inv); *(u32x2*)(optr + 16 * dt + 4 * jj) = w; }
}
__device__ __forceinline__ void swa_phase(const Frame& F) {
    LAS unsigned char* lds = F.lds + RING_OFF; const int tid = F.tid, lane = F.lane, wave = F.wave;
    LAS float* biasT = (LAS float*)(lds + SW_BIAS);
    for (int idx = tid; idx < 1024; idx += NWAVES * 64) { const int h = idx >> 7, d = idx & 127; biasT[idx] = F.in[I_RELB][t5_bucket(d) * 8 + h]; }
    constexpr int NPU = NBATCH * 32 * 2, NSU = NSS * 2;
    for (int u = F.vcu; u < NPU + NSU; u += F.G) {
        __syncthreads();
        if (u < NPU) {
            const int b = u >> 6, i = (u >> 1) & 31, kv = u & 1; const long m0 = (long)b * SEQ + 128 * i;
#pragma unroll
            for (int r = 0; r < 4; ++r) { const int id = tid + 512 * r, key = id >> 3, ch = id & 7; v4u v = (v4u){0u, 0u, 0u, 0u};
                if (i > 0 || key >= 128) v = *(const v4u*)(F.PROJ + (size_t)(m0 - 128 + key) * NPROJ + PK + kv * 64 + 8 * ch);
                *(LAS v4u*)(lds + SW_K + key * SW_KSTR + 16 * ch) = v; }
            { const int kg = tid >> 3, ch = tid & 7; v4u v[4];
#pragma unroll
              for (int r = 0; r < 4; ++r) { const int key = 4 * kg + r; v[r] = (v4u){0u, 0u, 0u, 0u}; if (i > 0 || key >= 128) v[r] = *(const v4u*)(F.PROJ + (size_t)(m0 - 128 + key) * NPROJ + PV + kv * 64 + 8 * ch); }
              const unsigned w0[4] = {v[0].x, v[0].y, v[0].z, v[0].w}, w1[4] = {v[1].x, v[1].y, v[1].z, v[1].w}, w2[4] = {v[2].x, v[2].y, v[2].z, v[2].w}, w3[4] = {v[3].x, v[3].y, v[3].z, v[3].w};
#pragma unroll
              for (int e2 = 0; e2 < 4; ++e2) {
                  u32x2 lo, hi; lo.x = (w0[e2] & 0xffffu) | (w1[e2] << 16); lo.y = (w2[e2] & 0xffffu) | (w3[e2] << 16);
                  hi.x = (w0[e2] >> 16) | (w1[e2] & 0xffff0000u); hi.y = (w2[e2] >> 16) | (w3[e2] & 0xffff0000u);
                  *(LAS u32x2*)(lds + SW_V + (8 * ch + 2 * e2) * SW_VSTR + 8 * kg) = lo; *(LAS u32x2*)(lds + SW_V + (8 * ch + 2 * e2 + 1) * SW_VSTR + 8 * kg) = hi; } }
            __syncthreads();
            const int qt = wave, c = lane & 15; const long mq = m0 + 16 * qt + c;
#pragma unroll 1
            for (int g = 0; g < 4; ++g) { const int head = kv * 4 + g;
                swa_item(lds, F.in[I_SINKS], qt, i == 0 ? 128 : 0, 15, F.PROJ + (size_t)mq * NPROJ + PQ + head * 64, 16 * qt + c, head, F.MIX + (size_t)mq * 1024 + 512 + head * 64, lane); }
        } else {
            const int su = u - NPU, s = su >> 1, kv = su & 1;
#pragma unroll
            for (int r = 0; r < 4; ++r) { const int id = tid + 512 * r, key = id >> 4, c4 = id & 15; const f32x4 v = *(const f32x4*)(F.in[I_CSWAK] + (((size_t)s * 128 + key) * 2 + kv) * 64 + 4 * c4);
                u32x2 w; w.x = pk2(v.x, v.y); w.y = pk2(v.z, v.w); *(LAS u32x2*)(lds + SW_K + key * SW_KSTR + 8 * c4) = w; }
            if (tid < 128) { const int key = 128 + (tid >> 3), ch = tid & 7; v4u v = (v4u){0u, 0u, 0u, 0u};
                if (key < 136) v = *(const v4u*)(F.PROJ + (size_t)(MP + s * TS + key - 128) * NPROJ + PK + kv * 64 + 8 * ch);
                *(LAS v4u*)(lds + SW_K + key * SW_KSTR + 16 * ch) = v; }
            { const int kg = tid >> 4, c4 = tid & 15; f32x4 v[4];
#pragma unroll
              for (int r = 0; r < 4; ++r) v[r] = *(const f32x4*)(F.in[I_CSWAV] + (((size_t)s * 128 + 4 * kg + r) * 2 + kv) * 64 + 4 * c4);
#pragma unroll
              for (int e = 0; e < 4; ++e) { u32x2 w; w.x = pk2(v[0][e], v[1][e]); w.y = pk2(v[2][e], v[3][e]); *(LAS u32x2*)(lds + SW_V + (4 * c4 + e) * SW_VSTR + 8 * kg) = w; } }
            if (tid < 32) { const int kg = 32 + (tid >> 3), ch = tid & 7; v4u v[4];
#pragma unroll
              for (int r = 0; r < 4; ++r) { const int key = 4 * kg + r; v[r] = (v4u){0u, 0u, 0u, 0u}; if (key < 136) v[r] = *(const v4u*)(F.PROJ + (size_t)(MP + s * TS + key - 128) * NPROJ + PV + kv * 64 + 8 * ch); }
              const unsigned w0[4] = {v[0].x, v[0].y, v[0].z, v[0].w}, w1[4] = {v[1].x, v[1].y, v[1].z, v[1].w}, w2[4] = {v[2].x, v[2].y, v[2].z, v[2].w}, w3[4] = {v[3].x, v[3].y, v[3].z, v[3].w};
#pragma unroll
              for (int e2 = 0; e2 < 4; ++e2) {
                  u32x2 lo, hi; lo.x = (w0[e2] & 0xffffu) | (w1[e2] << 16); lo.y = (w2[e2] & 0xffffu) | (w3[e2] << 16);
                  hi.x = (w0[e2] >> 16) | (w1[e2] & 0xffff0000u); hi.y = (w2[e2] >> 16) | (w3[e2] & 0xffff0000u);
                  *(LAS u32x2*)(lds + SW_V + (8 * ch + 2 * e2) * SW_VSTR + 8 * kg) = lo; *(LAS u32x2*)(lds + SW_V + (8 * ch + 2 * e2 + 1) * SW_VSTR + 8 * kg) = hi; } }
            __syncthreads();
            if (wave < 2) { const int c = lane & 15, t = c & 7, head = kv * 4 + 2 * wave + (c >> 3); const long mq = (long)MP + s * TS + t;
                swa_item(lds, F.in[I_SINKS], 0, 0, 8, F.PROJ + (size_t)mq * NPROJ + PQ + head * 64, t, head, F.MIX + (size_t)mq * 1024 + 512 + head * 64, lane); }
        }
    }
    __syncthreads();
}

constexpr int SD_TSTR = 272;
constexpr int SD_DTS = 0, SD_CSS = 4096, SD_A0 = 8192;
constexpr int S1_XT = SD_A0, S1_BT = S1_XT + 256 * SD_TSTR, S1_END = S1_BT + 128 * SD_TSTR;
constexpr int S2_C = SD_A0, S2_B = S2_C + 128 * SD_TSTR, S2_XT = S2_B + 128 * SD_TSTR, S2_RED = S2_XT + 256 * SD_TSTR, S2_END = S2_RED + 4 * 8 * 16 * 4;
static_assert(S2_END <= RING_BYTES && S1_END <= RING_BYTES, "SSD LDS map");

__device__ __forceinline__ void ssd_dtcs(const Frame& F, long m0) {
    const int h = F.wave; int lane = F.lane; asm volatile("" : "+v"(lane));
    LAS float* DTS = (LAS float*)(F.lds + SD_DTS); LAS float* CSS = (LAS float*)(F.lds + SD_CSS);
    const float A = -__expf(F.in[I_ALOG][h]), dtb = F.in[I_DTB][h];
    const float dt0 = softplus(F.DT[(size_t)(m0 + 2 * lane) * 8 + h] + dtb), dt1 = softplus(F.DT[(size_t)(m0 + 2 * lane + 1) * 8 + h] + dtb);
    const float a0 = dt0 * A, a1 = dt1 * A;
    float x = a0 + a1;
#pragma unroll
    for (int o = 1; o < 64; o <<= 1) { const float y = __shfl_up(x, o); if (lane >= o) x += y; }
    DTS[h * 128 + 2 * lane] = dt0; DTS[h * 128 + 2 * lane + 1] = dt1; CSS[h * 128 + 2 * lane] = x - a1; CSS[h * 128 + 2 * lane + 1] = x;
}
__device__ __forceinline__ void ssd_conv8(const Frame& F, long m0, bool first, int s0, int col0, float (&res)[8][8]) {
    const float* cw = F.in[I_CONVW]; const float* cb = F.in[I_CONVB];
    float w[4][8], bias[8];
#pragma unroll
    for (int k = 0; k < 4; ++k) { const f32x4 a = *(const f32x4*)(cw + k * 1024 + col0), b = *(const f32x4*)(cw + k * 1024 + col0 + 4);
        w[k][0] = a.x; w[k][1] = a.y; w[k][2] = a.z; w[k][3] = a.w; w[k][4] = b.x; w[k][5] = b.y; w[k][6] = b.z; w[k][7] = b.w; }
    { const f32x4 a = *(const f32x4*)(cb + col0), b = *(const f32x4*)(cb + col0 + 4); bias[0] = a.x; bias[1] = a.y; bias[2] = a.z; bias[3] = a.w; bias[4] = b.x; bias[5] = b.y; bias[6] = b.z; bias[7] = b.w; }
    v4u raw[11];
#pragma unroll
    for (int i = 0; i < 11; ++i) { raw[i] = (v4u){0u, 0u, 0u, 0u}; if (!(first && s0 + i < 3)) raw[i] = *(const v4u*)(F.PROJ + (size_t)(m0 + s0 - 3 + i) * NPROJ + PXBC + col0); }
#pragma unroll
    for (int s = 0; s < 8; ++s) {
#pragma unroll
        for (int e = 0; e < 8; ++e) res[s][e] = bias[e];
#pragma unroll
        for (int k = 0; k < 4; ++k) { const v4u r = raw[s + k];
            res[s][0] += w[k][0] * bflo(r.x); res[s][1] += w[k][1] * bfhi(r.x); res[s][2] += w[k][2] * bflo(r.y); res[s][3] += w[k][3] * bfhi(r.y);
            res[s][4] += w[k][4] * bflo(r.z); res[s][5] += w[k][5] * bfhi(r.z); res[s][6] += w[k][6] * bflo(r.w); res[s][7] += w[k][7] * bfhi(r.w); }
#pragma unroll
        for (int e = 0; e < 8; ++e) res[s][e] = silu(res[s][e]);
    }
}
__device__ __forceinline__ void ssd_put_T(LAS unsigned char* img, int row0, int s0, const float (&res)[8][8]) {
#pragma unroll
    for (int e = 0; e < 8; ++e) { v4u o; o.x = pk2(res[0][e], res[1][e]); o.y = pk2(res[2][e], res[3][e]); o.z = pk2(res[4][e], res[5][e]); o.w = pk2(res[6][e], res[7][e]);
        *(LAS v4u*)(img + (row0 + e) * SD_TSTR + 2 * s0) = o; }
}
__device__ __forceinline__ void ssd_put_R(LAS unsigned char* img, int s0, int c0, const float (&res)[8][8]) {
#pragma unroll
    for (int s = 0; s < 8; ++s) { v4u o; o.x = pk2(res[s][0], res[s][1]); o.y = pk2(res[s][2], res[s][3]); o.z = pk2(res[s][4], res[s][5]); o.w = pk2(res[s][6], res[s][7]);
        *(LAS v4u*)(img + (s0 + s) * SD_TSTR + 2 * c0) = o; }
}

__device__ __forceinline__ void ssd_states(const Frame& F) {
    LAS unsigned char* lds = F.lds + RING_OFF; const int wave = F.wave;
    const LAS float* DTS = (const LAS float*)(lds + SD_DTS); const LAS float* CSS = (const LAS float*)(lds + SD_CSS);
    for (int u = F.vcu; u < NBATCH * 32; u += F.G) {
        int tid = F.tid; asm volatile("" : "+v"(tid));
        const int lane = tid & 63, ar = lane & 15, jj = lane >> 4;
        const int b = u >> 5, c = u & 31; const long m0 = (long)b * SEQ + 128 * c;
        __syncthreads();
        ssd_dtcs(F, m0);
        __syncthreads();
        if (tid < 8) F.CD[u * 8 + tid] = __expf(CSS[tid * 128 + 127]);
#pragma unroll 1
        for (int g = 0; g < 2; ++g) {
            if (g) __syncthreads();
            { const int sb = tid & 15, chunk = tid >> 4, h = 4 * g + (chunk >> 3); float res[8][8];
              ssd_conv8(F, m0, c == 0, 8 * sb, g * 256 + 8 * chunk, res);
              const float cl = CSS[h * 128 + 127];
#pragma unroll
              for (int s = 0; s < 8; ++s) { const float wgt = DTS[h * 128 + 8 * sb + s] * __expf(cl - CSS[h * 128 + 8 * sb + s]);
#pragma unroll
                  for (int e = 0; e < 8; ++e) res[s][e] *= wgt; }
              ssd_put_T(lds + S1_XT, 8 * chunk, 8 * sb, res); }
            __builtin_amdgcn_sched_barrier(0);
            if (tid < 256) { const int sb = tid & 15, chunk = tid >> 4; float res[8][8];
              ssd_conv8(F, m0, c == 0, 8 * sb, 512 + g * 128 + 8 * chunk, res);
              ssd_put_T(lds + S1_BT, 8 * chunk, 8 * sb, res); }
            __syncthreads();
            f32x4 acc[2][8];
#pragma unroll
            for (int i = 0; i < 2; ++i)
#pragma unroll
                for (int nt = 0; nt < 8; ++nt) acc[i][nt] = (f32x4){0.f, 0.f, 0.f, 0.f};
#pragma unroll
            for (int ks = 0; ks < 4; ++ks) {
                bf16x8 a[2];
#pragma unroll
                for (int i = 0; i < 2; ++i) a[i] = *(const LAS bf16x8*)(lds + S1_XT + (16 * (2 * wave + i) + ar) * SD_TSTR + 64 * ks + 16 * jj);
#pragma unroll
                for (int nt = 0; nt < 8; ++nt) { const bf16x8 bf = *(const LAS bf16x8*)(lds + S1_BT + (16 * nt + ar) * SD_TSTR + 64 * ks + 16 * jj);
                    acc[0][nt] = MFMA16(a[0], bf, acc[0][nt]); acc[1][nt] = MFMA16(a[1], bf, acc[1][nt]); }
                __builtin_amdgcn_sched_barrier(0);
            }
            float* stp = F.ST + ((size_t)u * 8 + 4 * g) * 8192 + (size_t)(32 * wave + 4 * jj) * 128 + ar;
#pragma unroll
            for (int i = 0; i < 2; ++i)
#pragma unroll
                for (int nt = 0; nt < 8; ++nt)
#pragma unroll
                    for (int r = 0; r < 4; ++r) stp[(size_t)(16 * i + r) * 128 + 16 * nt] = acc[i][nt][r];
        }
    }
    __syncthreads();
}

__device__ __forceinline__ void ssd_scan(const Frame& F) {
    for (int e = F.vcu * (NWAVES * 64) + F.tid; e < NBATCH * 16384; e += F.G * NWAVES * 64) {
        const int b = e >> 14, rem = e & 16383, h = rem >> 11;
        f32x4 cur = (f32x4){0.f, 0.f, 0.f, 0.f};
#pragma unroll 1
        for (int c0 = 0; c0 < 32; c0 += 8) {
            f32x4 st[8]; float cd[8];
#pragma unroll
            for (int i = 0; i < 8; ++i) { st[i] = *(const f32x4*)(F.ST + (size_t)(b * 32 + c0 + i) * 65536 + (size_t)rem * 4); cd[i] = F.CD[(b * 32 + c0 + i) * 8 + h]; }
#pragma unroll
            for (int i = 0; i < 8; ++i) { u32x2 w; w.x = pk2(cur.x, cur.y); w.y = pk2(cur.z, cur.w); *(u32x2*)(F.HS + (size_t)(b * 32 + c0 + i) * 65536 + (size_t)rem * 4) = w; cur = cur * cd[i] + st[i]; }
        }
        *(f32x4*)(F.out + O_PSSM + (size_t)b * 65536 + (size_t)rem * 4) = cur;
    }
}

__device__ __forceinline__ void ssd_output(const Frame& F) {
    LAS unsigned char* lds = F.lds + RING_OFF; const int wave = F.wave;
    const LAS float* DTS = (const LAS float*)(lds + SD_DTS); const LAS float* CSS = (const LAS float*)(lds + SD_CSS); LAS float* RED = (LAS float*)(lds + S2_RED);
    const float* gn = F.in[I_GSSD];
    for (int u = F.vcu; u < NBATCH * 32; u += F.G) {
        int tid = F.tid; asm volatile("" : "+v"(tid));
        const int lane = tid & 63, ar = lane & 15, jj = lane >> 4;
        const int b = u >> 5, c = u & 31; const long m0 = (long)b * SEQ + 128 * c;
        __syncthreads();
        ssd_dtcs(F, m0);
#pragma unroll 1
        for (int g = 0; g < 2; ++g) {
            __syncthreads();
            { const int sb = tid & 15, chunk = tid >> 4; float res[8][8];
              ssd_conv8(F, m0, c == 0, 8 * sb, g * 256 + 8 * chunk, res);
              ssd_put_T(lds + S2_XT, 8 * chunk, 8 * sb, res); }
            __builtin_amdgcn_sched_barrier(0);
            { const int t2 = tid & 255, chunk = t2 & 15, sb = t2 >> 4; float res[8][8];
              ssd_conv8(F, m0, c == 0, 8 * sb, (tid < 256 ? 512 : 768) + g * 128 + 8 * chunk, res);
              ssd_put_R(lds + (tid < 256 ? S2_B : S2_C), 8 * sb, 8 * chunk, res); }
            __syncthreads();
            const int pi = wave & 3, hh = wave >> 2;
#pragma unroll 1
            for (int it = 0; it < 2; ++it) {
                const int qt = it ? 7 - pi : pi, q = 16 * qt + ar;
                bf16x8 cf[4];
#pragma unroll
                for (int ks = 0; ks < 4; ++ks) cf[ks] = *(const LAS bf16x8*)(lds + S2_C + q * SD_TSTR + 64 * ks + 16 * jj);
                f32x4 cbt[8];
#pragma unroll
                for (int st = 0; st < 8; ++st) { cbt[st] = (f32x4){0.f, 0.f, 0.f, 0.f};
                    if (st <= qt) {
#pragma unroll
                        for (int ks = 0; ks < 4; ++ks) { const bf16x8 a = *(const LAS bf16x8*)(lds + S2_B + (16 * st + ar) * SD_TSTR + 64 * ks + 16 * jj); cbt[st] = MFMA16(a, cf[ks], cbt[st]); } }
                    __builtin_amdgcn_sched_barrier(0); }
                float ss = 0.f;
#pragma unroll 1
                for (int hs = 0; hs < 2; ++hs) {
                    const int hl = 2 * hh + hs, hg = 4 * g + hl;
                    const bf16* hsp = F.HS + ((size_t)u * 8 + hg) * 8192 + (size_t)ar * 128 + 8 * jj;
                    bf16x8 hf[4][4];
#pragma unroll
                    for (int pt = 0; pt < 4; ++pt)
#pragma unroll
                        for (int ks = 0; ks < 4; ++ks) hf[pt][ks] = *(const bf16x8*)(hsp + (size_t)(16 * pt) * 128 + 32 * ks);
                    u32x2 zr[4];
#pragma unroll
                    for (int pt = 0; pt < 4; ++pt) zr[pt] = *(const u32x2*)(F.PROJ + (size_t)(m0 + q) * NPROJ + PZ + hg * 64 + 16 * pt + 4 * jj);
                    const float csq = CSS[hg * 128 + q], eq = __expf(csq);
                    f32x4 acc[4];
#pragma unroll
                    for (int pt = 0; pt < 4; ++pt) acc[pt] = (f32x4){0.f, 0.f, 0.f, 0.f};
                    __builtin_amdgcn_sched_barrier(0);
#pragma unroll
                    for (int uu = 0; uu < 4; ++uu) {
                        if (2 * uu <= qt) {
                            f32x4 mA, mB;
                            { const int sbase = 32 * uu + 4 * jj; const f32x4 css = *(const LAS f32x4*)(CSS + hg * 128 + sbase), dts = *(const LAS f32x4*)(DTS + hg * 128 + sbase);
#pragma unroll
                              for (int r = 0; r < 4; ++r) { const int s = sbase + r; const float d = fminf(csq - css[r], 0.f); mA[r] = (s <= q) ? cbt[2 * uu][r] * __expf(d) * dts[r] : 0.f; } }
                            { const int sbase = 32 * uu + 16 + 4 * jj; const f32x4 css = *(const LAS f32x4*)(CSS + hg * 128 + sbase), dts = *(const LAS f32x4*)(DTS + hg * 128 + sbase);
#pragma unroll
                              for (int r = 0; r < 4; ++r) { const int s = sbase + r; const float d = fminf(csq - css[r], 0.f); mB[r] = (s <= q) ? cbt[2 * uu + 1][r] * __expf(d) * dts[r] : 0.f; } }
                            const bf16x8 pb = pack_p(mA, mB);
#pragma unroll
                            for (int pt = 0; pt < 4; ++pt) { const LAS unsigned char* xrow = lds + S2_XT + (hl * 64 + 16 * pt + ar) * SD_TSTR + 64 * uu + 8 * jj;
                                const s16x4 lo = *(const LAS s16x4*)(xrow), hi = *(const LAS s16x4*)(xrow + 32); acc[pt] = MFMA16(cat8(lo, hi), pb, acc[pt]); }
                        }
                        __builtin_amdgcn_sched_barrier(0);
                    }
                    const float dsk = F.in[I_DSKIP][hg];
#pragma unroll
                    for (int pt = 0; pt < 4; ++pt) {
                        f32x4 ao = (f32x4){0.f, 0.f, 0.f, 0.f};
#pragma unroll
                        for (int ks = 0; ks < 4; ++ks) ao = MFMA16(hf[pt][ks], cf[ks], ao);
                        const float z[4] = {bflo(zr[pt].x), bfhi(zr[pt].x), bflo(zr[pt].y), bfhi(zr[pt].y)};
                        float y[4];
#pragma unroll
                        for (int r = 0; r < 4; ++r) { const float xs = bf2f(*(const LAS unsigned short*)(lds + S2_XT + (hl * 64 + 16 * pt + 4 * jj + r) * SD_TSTR + 2 * q));
                            y[r] = (acc[pt][r] + eq * ao[r] + dsk * xs) * silu(z[r]); ss += y[r] * y[r]; }
                        u32x2 w; w.x = pk2(y[0], y[1]); w.y = pk2(y[2], y[3]);
                        *(u32x2*)(F.MIX + (size_t)(m0 + q) * 1024 + hg * 64 + 16 * pt + 4 * jj) = w;
                    }
                }
                ss += __shfl_xor(ss, 16); ss += __shfl_xor(ss, 32);
                LAS float* red = RED + (2 * g + it) * 128;
                if (jj == 0) red[wave * 16 + ar] = ss;
                __syncthreads();
                const float tot = ss + red[(wave ^ 4) * 16 + ar];
                const float rs = 1.0f / sqrtf(tot * (1.0f / 256.0f) + EPS);
#pragma unroll 1
                for (int hs = 0; hs < 2; ++hs) { const int hg = 4 * g + 2 * hh + hs;
#pragma unroll
                    for (int pt = 0; pt < 4; ++pt) { const int col = hg * 64 + 16 * pt + 4 * jj; const f32x4 gv = *(const f32x4*)(gn + col);
                        u32x2* mp = (u32x2*)(F.MIX + (size_t)(m0 + q) * 1024 + col); const u32x2 v = *mp;
                        u32x2 w; w.x = pk2(bflo(v.x) * rs * gv.x, bfhi(v.x) * rs * gv.y); w.y = pk2(bflo(v.y) * rs * gv.z, bfhi(v.y) * rs * gv.w);
                        *mp = w; } }
            }
        }
    }
    __syncthreads();
}
constexpr int CX_KSTR = 272, CX_VSTR = 528;
constexpr int CX_K = 0, CX_V = 256 * CX_KSTR, CX_END = CX_V + 128 * CX_VSTR;
__device__ __forceinline__ void cx_item(const LAS unsigned char* lds, const bf16* qptr, bf16* optr, bool ostore, int lane) {
    const int ar = lane & 15, jj = lane >> 4;
    const LAS unsigned char* Kl = lds + CX_K; const LAS unsigned char* Vl = lds + CX_V;
    bf16x8 qf[4];
#pragma unroll
    for (int ks = 0; ks < 4; ++ks) qf[ks] = *(const bf16x8*)(qptr + 32 * ks + 8 * jj);
    f32x4 sacc[16];
#pragma unroll
    for (int kt = 0; kt < 16; ++kt) { sacc[kt] = (f32x4){0.f, 0.f, 0.f, 0.f};
#pragma unroll
        for (int ks = 0; ks < 4; ++ks) { const bf16x8 a = *(const LAS bf16x8*)(Kl + (16 * kt + ar) * CX_KSTR + 64 * ks + 16 * jj); sacc[kt] = MFMA16(a, qf[ks], sacc[kt]); }
        __builtin_amdgcn_sched_barrier(0); }
    float mx = -INFINITY;
#pragma unroll
    for (int kt = 0; kt < 16; ++kt)
#pragma unroll
        for (int r = 0; r < 4; ++r) mx = fmaxf(mx, sacc[kt][r]);
    mx = fmaxf(mx, __shfl_xor(mx, 16)); mx = fmaxf(mx, __shfl_xor(mx, 32));
    float sum = 0.f;
#pragma unroll
    for (int kt = 0; kt < 16; ++kt)
#pragma unroll
        for (int r = 0; r < 4; ++r) { const float p = __expf(sacc[kt][r] - mx); sacc[kt][r] = p; sum += p; }
    sum += __shfl_xor(sum, 16); sum += __shfl_xor(sum, 32);
    const float inv = 1.0f / sum;
    f32x4 oacc[8];
#pragma unroll
    for (int dt = 0; dt < 8; ++dt) oacc[dt] = (f32x4){0.f, 0.f, 0.f, 0.f};
#pragma unroll
    for (int u = 0; u < 8; ++u) {
        const bf16x8 pb = pack_p(sacc[2 * u], sacc[2 * u + 1]);
#pragma unroll
        for (int dt = 0; dt < 8; ++dt) {
            const LAS unsigned char* vrow = Vl + (16 * dt + ar) * CX_VSTR + 8 * jj + 64 * u;
            const s16x4 lo = *(const LAS s16x4*)(vrow), hi = *(const LAS s16x4*)(vrow + 32);
            oacc[dt] = MFMA16(cat8(lo, hi), pb, oacc[dt]);
        }
        __builtin_amdgcn_sched_barrier(0);
    }
    if (ostore) {
#pragma unroll
        for (int dt = 0; dt < 8; ++dt) { u32x2 w; w.x = pk2(oacc[dt][0] * inv, oacc[dt][1] * inv); w.y = pk2(oacc[dt][2] * inv, oacc[dt][3] * inv); *(u32x2*)(optr + 16 * dt + 4 * jj) = w; }
    }
}
__device__ __forceinline__ void cx_phase(const Frame& F) {
    LAS unsigned char* lds = F.lds + RING_OFF; const int tid = F.tid, lane = F.lane, wave = F.wave;
    constexpr int NPU = NBATCH * 4 * 8, NSU = NSS * 4;
    for (int u = F.vcu; u < NPU + NSU; u += F.G) {
        __syncthreads();
        if (u < NPU) {
            const int b = u >> 5, head = (u >> 3) & 3, qc = u & 7;
#pragma unroll
            for (int r = 0; r < 8; ++r) { const int id = tid + 512 * r, key = id >> 4, ch = id & 15;
                *(LAS v4u*)(lds + CX_K + key * CX_KSTR + 16 * ch) = *(const v4u*)(F.MKVB + (size_t)(b * NMEM + key) * 1024 + head * 128 + 8 * ch); }
#pragma unroll
            for (int r2 = 0; r2 < 2; ++r2) { const int id = tid + 512 * r2, kg = id >> 4, ch = id & 15; v4u v[4];
#pragma unroll
              for (int r = 0; r < 4; ++r) v[r] = *(const v4u*)(F.MKVB + (size_t)(b * NMEM + 4 * kg + r) * 1024 + 512 + head * 128 + 8 * ch);
              const unsigned w0[4] = {v[0].x, v[0].y, v[0].z, v[0].w}, w1[4] = {v[1].x, v[1].y, v[1].z, v[1].w}, w2[4] = {v[2].x, v[2].y, v[2].z, v[2].w}, w3[4] = {v[3].x, v[3].y, v[3].z, v[3].w};
#pragma unroll
              for (int e2 = 0; e2 < 4; ++e2) {
                  u32x2 lo, hi; lo.x = (w0[e2] & 0xffffu) | (w1[e2] << 16); lo.y = (w2[e2] & 0xffffu) | (w3[e2] << 16);
                  hi.x = (w0[e2] >> 16) | (w1[e2] & 0xffff0000u); hi.y = (w2[e2] >> 16) | (w3[e2] & 0xffff0000u);
                  *(LAS u32x2*)(lds + CX_V + (8 * ch + 2 * e2) * CX_VSTR + 8 * kg) = lo; *(LAS u32x2*)(lds + CX_V + (8 * ch + 2 * e2 + 1) * CX_VSTR + 8 * kg) = hi; } }
            __syncthreads();
#pragma unroll 1
            for (int i = 0; i < 4; ++i) { const long mq = (long)b * SEQ + 512 * qc + 16 * (4 * wave + i) + (lane & 15);
                cx_item(lds, F.QC + (size_t)mq * CA + head * 128, F.OC + (size_t)mq * CA + head * 128, true, lane); }
        } else {
            const int su = u - NPU, s = su >> 2, head = su & 3;
#pragma unroll
            for (int r = 0; r < 16; ++r) { const int id = tid + 512 * r, key = id >> 5, c4 = id & 31; const f32x4 v = *(const f32x4*)(F.in[I_CMEMK] + (((size_t)s * NMEM + key) * 4 + head) * 128 + 4 * c4);
                u32x2 w; w.x = pk2(v.x, v.y); w.y = pk2(v.z, v.w); *(LAS u32x2*)(lds + CX_K + key * CX_KSTR + 8 * c4) = w; }
#pragma unroll
            for (int r2 = 0; r2 < 4; ++r2) { const int id = tid + 512 * r2, kg = id >> 5, c4 = id & 31; f32x4 v[4];
#pragma unroll
              for (int r = 0; r < 4; ++r) v[r] = *(const f32x4*)(F.in[I_CMEMV] + (((size_t)s * NMEM + 4 * kg + r) * 4 + head) * 128 + 4 * c4);
#pragma unroll
              for (int e = 0; e < 4; ++e) { u32x2 w; w.x = pk2(v[0][e], v[1][e]); w.y = pk2(v[2][e], v[3][e]); *(LAS u32x2*)(lds + CX_V + (4 * c4 + e) * CX_VSTR + 8 * kg) = w; } }
            __syncthreads();
            if (wave == 0) { const int c = lane & 15; const long mq = (long)MP + s * TS + (c & 7);
                cx_item(lds, F.QC + (size_t)mq * CA + head * 128, F.OC + (size_t)mq * CA + head * 128, c < 8, lane); }
        }
    }
    __syncthreads();
}
constexpr int MG_STR = 144, MG_TILE = 128 * MG_STR;
template <class Epi> __device__ __forceinline__ void mini_gemm(const Frame& F, const bf16* A, int K, const bf16* Bt, int npc, const Epi& E, int first_wg) {
    LAS unsigned char* lds = F.lds + RING_OFF;
    const int nc = K / 64;
    for (int pc = (int)((blockIdx.x + F.G - first_wg) % F.G); pc < 8 * npc; pc += F.G) {
        int tid = F.tid; asm volatile("" : "+v"(tid));
        const int lane = tid & 63, ar = lane & 15, jj = lane >> 4, wr = F.wave >> 2, wc = F.wave & 3;
        const int rb = pc / npc, cb = pc % npc;
        const int r0 = tid >> 3, ch = tid & 7;
        const bf16* ag0 = A + (size_t)(MP + 128 * rb + r0) * K + 8 * ch; const bf16* ag1 = ag0 + (size_t)64 * K;
        const bf16* bg0 = Bt + (size_t)E.grow(cb, r0) * K + 8 * ch; const bf16* bg1 = Bt + (size_t)E.grow(cb, r0 + 64) * K + 8 * ch;
        const int so0 = r0 * MG_STR + 16 * ch, so1 = so0 + 64 * MG_STR;
        v4u a0 = *(const v4u*)ag0, a1 = *(const v4u*)ag1, b0 = *(const v4u*)bg0, b1 = *(const v4u*)bg1;
        *(LAS v4u*)(lds + so0) = a0; *(LAS v4u*)(lds + so1) = a1; *(LAS v4u*)(lds + MG_TILE + so0) = b0; *(LAS v4u*)(lds + MG_TILE + so1) = b1;
        __syncthreads();
        f32x4 acc[4][2];
#pragma unroll
        for (int mt = 0; mt < 4; ++mt) { acc[mt][0] = (f32x4){0.f, 0.f, 0.f, 0.f}; acc[mt][1] = (f32x4){0.f, 0.f, 0.f, 0.f}; }
        const int aoff = (64 * wr + ar) * MG_STR + 16 * jj, boff0 = MG_TILE + (E.bsel(wc, 0) + ar) * MG_STR + 16 * jj, boff1 = MG_TILE + (E.bsel(wc, 1) + ar) * MG_STR + 16 * jj;
#pragma unroll 1
        for (int c = 0; c < nc; ++c) {
            const bool more = c + 1 < nc;
            if (more) { a0 = *(const v4u*)(ag0 + 64 * (c + 1)); a1 = *(const v4u*)(ag1 + 64 * (c + 1)); b0 = *(const v4u*)(bg0 + 64 * (c + 1)); b1 = *(const v4u*)(bg1 + 64 * (c + 1)); }
            const LAS unsigned char* buf = lds + (c & 1) * 2 * MG_TILE;
#pragma unroll
            for (int ks = 0; ks < 2; ++ks) {
                const bf16x8 bf0 = *(const LAS bf16x8*)(buf + boff0 + 64 * ks), bf1 = *(const LAS bf16x8*)(buf + boff1 + 64 * ks);
#pragma unroll
                for (int mt = 0; mt < 4; ++mt) { const bf16x8 af = *(const LAS bf16x8*)(buf + aoff + 16 * mt * MG_STR + 64 * ks);
                    acc[mt][0] = MFMA16(bf0, af, acc[mt][0]); acc[mt][1] = MFMA16(bf1, af, acc[mt][1]); }
            }
            if (more) { LAS unsigned char* nb = lds + ((c + 1) & 1) * 2 * MG_TILE;
                *(LAS v4u*)(nb + so0) = a0; *(LAS v4u*)(nb + so1) = a1; *(LAS v4u*)(nb + MG_TILE + so0) = b0; *(LAS v4u*)(nb + MG_TILE + so1) = b1; }
            __syncthreads();
        }
        E.store(acc, MP + 128 * rb + 64 * wr + ar, cb, wc, jj);
    }
}
__device__ __forceinline__ u32x2 pack4(const f32x4& v) { u32x2 w; w.x = pk2(v[0], v[1]); w.y = pk2(v[2], v[3]); return w; }
__device__ __forceinline__ float mg_rstd(const float* ssq, int row) {
    const float* p = ssq + (size_t)(row - MP) * 32; float s = 0.f;
#pragma unroll
    for (int i = 0; i < 8; ++i) { const f32x4 a = *(const f32x4*)(p + 4 * i); s += (a.x + a.y) + (a.z + a.w); }
    return 1.0f / sqrtf(s * (1.0f / 1024.0f) + EPS);
}
struct MgStd { __device__ __forceinline__ int grow(int cb, int i) const { return 128 * cb + i; } __device__ __forceinline__ int bsel(int wc, int nt) const { return 32 * wc + 16 * nt; } };
struct MgBf16 : MgStd { bf16* O; int ldc;
    __device__ __forceinline__ void store(const f32x4 (&acc)[4][2], int row0, int cb, int wc, int jj) const {
#pragma unroll
        for (int mt = 0; mt < 4; ++mt)
#pragma unroll
            for (int nt = 0; nt < 2; ++nt) *(u32x2*)(O + (size_t)(row0 + 16 * mt) * ldc + 128 * cb + 32 * wc + 16 * nt + 4 * jj) = pack4(acc[mt][nt]); } };
struct MgScale : MgStd { bf16* O; int ldc; const float* ssq; float scale;
    __device__ __forceinline__ void store(const f32x4 (&acc)[4][2], int row0, int cb, int wc, int jj) const {
#pragma unroll
        for (int mt = 0; mt < 4; ++mt) { const float r = mg_rstd(ssq, row0 + 16 * mt) * scale;
#pragma unroll
            for (int nt = 0; nt < 2; ++nt) *(u32x2*)(O + (size_t)(row0 + 16 * mt) * ldc + 128 * cb + 32 * wc + 16 * nt + 4 * jj) = pack4(acc[mt][nt] * r); } } };
template <bool BASE_BF16> struct MgResid : MgStd { const void* base; size_t base_row0; bf16* ob; float* ssq;
    __device__ __forceinline__ void store(const f32x4 (&acc)[4][2], int row0, int cb, int wc, int jj) const {
#pragma unroll
        for (int mt = 0; mt < 4; ++mt) { const int row = row0 + 16 * mt; float ss = 0.f;
#pragma unroll
            for (int nt = 0; nt < 2; ++nt) { const int c = 128 * cb + 32 * wc + 16 * nt + 4 * jj; f32x4 b;
                if (BASE_BF16) { const u32x2 w = *(const u32x2*)((const bf16*)base + ((size_t)row - base_row0) * 1024 + c); b = (f32x4){bflo(w.x), bfhi(w.x), bflo(w.y), bfhi(w.y)}; }
                else b = *(const f32x4*)((const float*)base + ((size_t)row - base_row0) * 1024 + c);
                const f32x4 v = b + acc[mt][nt]; ss += (v[0] * v[0] + v[1] * v[1]) + (v[2] * v[2] + v[3] * v[3]);
                *(u32x2*)(ob + (size_t)row * 1024 + c) = pack4(v); }
            ss += __shfl_xor(ss, 16); ss += __shfl_xor(ss, 32);
            if (jj == 0) ssq[(size_t)(row - MP) * 32 + 4 * cb + wc] = ss; } } };
struct MgSwiGLU { bf16* O; const float* ssq;
    __device__ __forceinline__ int grow(int cb, int i) const { const int f0 = 64 * cb, base = (f0 >> 7) * 256 + (f0 & 127); return i < 64 ? base + i : base + 128 + (i - 64); }
    __device__ __forceinline__ int bsel(int wc, int nt) const { return 16 * wc + 64 * nt; }
    __device__ __forceinline__ void store(const f32x4 (&acc)[4][2], int row0, int cb, int wc, int jj) const {
#pragma unroll
        for (int mt = 0; mt < 4; ++mt) { const int row = row0 + 16 * mt; const float r = mg_rstd(ssq, row); f32x4 h;
#pragma unroll
            for (int e = 0; e < 4; ++e) { const float g = acc[mt][0][e] * r, up = acc[mt][1][e] * r; h[e] = silu(g) * up; }
            *(u32x2*)(O + (size_t)row * DFF + 64 * cb + 16 * wc + 4 * jj) = pack4(h); } } };

#ifndef MK_N_LAUNCHES
#define MK_N_LAUNCHES 1
#endif
constexpr int NPH = 12;
constexpr int N_LAUNCHES = MK_N_LAUNCHES;
struct Args { const float* in[31]; float* out; unsigned char* ws; int ph_lo, ph_hi, li, pad; };
__global__ void __launch_bounds__(NWAVES * 64, 2) skel_fwd(Args args) {
    extern __shared__ __attribute__((aligned(16))) unsigned char lds[];
    Frame F;
    F.lds = (LAS unsigned char*)lds;
    F.MISC = (volatile LAS unsigned*)(F.lds + MISC_OFF);
    F.tid = threadIdx.x; F.lane = F.tid & 63; F.wave = __builtin_amdgcn_readfirstlane(F.tid >> 6);
    F.G = gridDim.x; { const int bx = blockIdx.x; F.vcu = (F.G % 8 == 0) ? (bx % 8) * (F.G / 8) + bx / 8 : bx; }
    unsigned char* ws = args.ws;
    F.ctl = (gu32*)(ws + WS_CTL);
    F.in = (const float* const __attribute__((address_space(4)))*)__builtin_amdgcn_kernarg_segment_ptr();
    F.out = args.out;
    F.Win_t = (bf16*)(ws + WS_WIN); F.Wout_t = (bf16*)(ws + WS_WOUT); F.Wcq_t = (bf16*)(ws + WS_WCQ); F.Wckv_t = (bf16*)(ws + WS_WCKV); F.Wco_t = (bf16*)(ws + WS_WCO);
    F.Wgu_t = (bf16*)(ws + WS_WGU); F.Wd_t = (bf16*)(ws + WS_WD);
    F.DT = (float*)(ws + WS_DT); F.SSQ1 = (float*)(ws + WS_SSQ1); F.SSQ2 = (float*)(ws + WS_SSQ2); F.SSQ3 = (float*)(ws + WS_SSQ3); F.YS = (float*)(ws + WS_YSS) - (size_t)MP * 512; F.ST = (float*)(ws + WS_R3); F.CD = (float*)(ws + WS_CD); F.SSQS1 = (float*)(ws + WS_CD + 1 * MiB); F.SSQS2 = (float*)(ws + WS_CD + 2 * MiB); F.SSQS3 = (float*)(ws + WS_CD + 3 * MiB); F.HS = (bf16*)(ws + WS_HS);
    F.MN = (bf16*)(ws + WS_MN); F.MKVB = (bf16*)(ws + WS_MKVB); F.XN = (bf16*)(ws + WS_R1); F.MIX = (bf16*)(ws + WS_R1); F.PROJ = (bf16*)(ws + WS_R2); F.HM = (bf16*)(ws + WS_R2);
    F.XC = (bf16*)(ws + WS_XCS) - (size_t)MP * 1024; F.QC = (bf16*)(ws + WS_R3); F.OC = (bf16*)(ws + WS_R3 + 33 * MiB); F.HB = (bf16*)(ws + WS_HB);
    { int t0 = threadIdx.x; asm volatile("" : "+v"(t0));
      for (int u = t0; u < (LDS_BYTES - LDSCTL_OFF) / 4; u += NWAVES * 64) ((LAS unsigned*)(F.lds + LDSCTL_OFF))[u] = 0u; }
    __syncthreads();
    XcdBarrier bar; bar.bar = (unsigned*)(F.ctl + CW_BAR); bar.x = 0; bar.st = nullptr;
    if (N_LAUNCHES == 1) bar = xcd_barrier_post((unsigned*)(F.ctl + CW_BAR), F.MISC + 8);
#define GRID_BAR() do { if (N_LAUNCHES == 1) { xcd_barrier(bar); } } while (0)
    const int lo = args.ph_lo, hi = args.ph_hi;
#define IN(k) (lo <= (k) && (k) < hi)
#define SEAM(k) do { if (IN(k) && IN((k) + 1)) GRID_BAR(); } while (0)
    if (IN(0)) { p0_prologue(F); VM_WAIT(); __syncthreads(); } SEAM(0);
    if (IN(1)) {
        constexpr int nt1 = (MP / 256) * (NPROJ / 256);
        { pg8::Gemm g{F.XN, F.Win_t, MP, NPROJ, DM}; pg8::StaticOrder S; S.init(MP, NPROJ, F.G, (int)blockIdx.x); pg8::EpiBf16P E{F.PROJ, NPROJ};
          pg8::gemm_phase<pg8::EpiBf16P, pg8::StaticOrder, true, true>(F.lds + RING_OFF, g, S, E); }
        { pg8::Gemm g{F.MN, F.Wckv_t, NBATCH * NMEM, 1024, DM}; pg8::StaticOrder S;
          S.init(NBATCH * NMEM, 1024, F.G, (int)((blockIdx.x + F.G - (nt1 % F.G)) % F.G)); pg8::EpiMemKV E{F.out + O_PMEMK, F.out + O_PMEMV, F.MKVB};
          pg8::gemm_phase<pg8::EpiMemKV, pg8::StaticOrder, true, true>(F.lds + RING_OFF, g, S, E); }
        { MgBf16 E; E.O = F.PROJ; E.ldc = NPROJ; mini_gemm(F, F.XN, DM, F.Win_t, NPROJ / 128, E, (nt1 + 32) % 256); }
    } SEAM(1);
    if (IN(2)) { ssd_states(F); n1_conv(F); } SEAM(2);
    if (IN(3)) { ssd_scan(F); n2_ssd(F); } SEAM(3);
    if (IN(4)) { ssd_output(F); n3_gate(F); swa_phase(F); } SEAM(4);
    if (IN(5)) {
        { pg8::Gemm g{F.MIX, F.Wout_t, MP, DM, DM}; pg8::StaticOrder S; S.init(MP, DM, F.G, (int)blockIdx.x); pg8::EpiResidB<false> E{F.in[I_XP], F.HB, F.SSQ1};
          pg8::gemm_phase<pg8::EpiResidB<false>, pg8::StaticOrder, true, true>(F.lds + RING_OFF, g, S, E); }
        { MgResid<false> E; E.base = F.in[I_XS]; E.base_row0 = MP; E.ob = F.HB; E.ssq = F.SSQS1; mini_gemm(F, F.MIX, DM, F.Wout_t, 8, E, 0); }
    } SEAM(5);
    if (IN(6)) {
        { pg8::Gemm g{F.HB, F.Wcq_t, MP, CA, DM}; pg8::StaticOrder S; S.init(MP, CA, F.G, (int)blockIdx.x); pg8::EpiScaleBf16 E{F.QC, CA, F.SSQ1, 0.08838834764831845f};
          pg8::gemm_phase<pg8::EpiScaleBf16, pg8::StaticOrder, true, true>(F.lds + RING_OFF, g, S, E); }
        { MgScale E; E.O = F.QC; E.ldc = CA; E.ssq = F.SSQS1; E.scale = 0.08838834764831845f; mini_gemm(F, F.HB, DM, F.Wcq_t, 4, E, 0); }
    } SEAM(6);
    if (IN(7)) { cx_phase(F); } SEAM(7);
    if (IN(8)) {
        { pg8::Gemm g{F.OC, F.Wco_t, MP, DM, CA}; pg8::StaticOrder S; S.init(MP, DM, F.G, (int)blockIdx.x); pg8::EpiResidB<true> E{F.HB, F.HB, F.SSQ2};
          pg8::gemm_phase<pg8::EpiResidB<true>, pg8::StaticOrder, true, true>(F.lds + RING_OFF, g, S, E); }
        { MgResid<true> E; E.base = F.HB; E.base_row0 = 0; E.ob = F.HB; E.ssq = F.SSQS2; mini_gemm(F, F.OC, CA, F.Wco_t, 8, E, 0); }
    } SEAM(8);
    if (IN(9)) {
        { pg8::Gemm g{F.HB, F.Wgu_t, MP, 2 * DFF, DM}; pg8::StaticOrder S; S.init(MP, 2 * DFF, F.G, (int)blockIdx.x); pg8::EpiSwiGLU E{F.HM, DFF, F.SSQ2};
          pg8::gemm_phase<pg8::EpiSwiGLU, pg8::StaticOrder, true, true>(F.lds + RING_OFF, g, S, E); }
        { MgSwiGLU E; E.O = F.HM; E.ssq = F.SSQS2; mini_gemm(F, F.HB, DM, F.Wgu_t, DFF / 64, E, 0); }
    } SEAM(9);
    if (IN(10)) {
        { pg8::Gemm g{F.HM, F.Wd_t, MP, DM, DFF}; pg8::StaticOrder S; S.init(MP, DM, F.G, (int)blockIdx.x); pg8::EpiResidB<true> E{F.HB, F.HB, F.SSQ3};
          pg8::gemm_phase<pg8::EpiResidB<true>, pg8::StaticOrder, true, true>(F.lds + RING_OFF, g, S, E); }
        { MgResid<true> E; E.base = F.HB; E.base_row0 = 0; E.ob = F.HB; E.ssq = F.SSQS3; mini_gemm(F, F.HM, DFF, F.Wd_t, 8, E, 0); }
    } SEAM(10);
    if (IN(11)) { p11_final(F); }
#undef IN
#undef SEAM
}

extern "C" void kernel_launch(void* const* d_in, const int* in_sizes, int n_in, void* d_out, int out_size, void* d_ws, size_t ws_size, hipStream_t stream) {
    static int grid = 0;
    if (grid == 0) {
        if (n_in != 31 || out_size != (int)O_END || ws_size < WS_END) { fprintf(stderr, "kernel_launch: unexpected shapes: n_in %d out %d ws %zu\n", n_in, out_size, ws_size); grid = -1; return; }
        int dev = 0, cus = 0;
        if (hipGetDevice(&dev) != hipSuccess || hipDeviceGetAttribute(&cus, hipDeviceAttributeMultiprocessorCount, dev) != hipSuccess) { grid = -1; return; }
        if (hipFuncSetAttribute((const void*)skel_fwd, hipFuncAttributeMaxDynamicSharedMemorySize, LDS_BYTES) != hipSuccess) { fprintf(stderr, "kernel_launch: hipFuncSetAttribute failed\n"); grid = -1; return; }
        (void)hipGetLastError();
        grid = cus;
    }
    if (grid < 0) return;
    if (hipMemsetAsync((char*)d_ws + WS_CTL, 0, CTL_ZERO_BYTES, stream) != hipSuccess) { fprintf(stderr, "kernel_launch: memset failed\n"); return; }
    Args a{};
    for (int i = 0; i < 31; ++i) a.in[i] = (const float*)d_in[i];
    a.out = (float*)d_out; a.ws = (unsigned char*)d_ws;
    for (int li = 0; li < N_LAUNCHES; ++li) {
        a.ph_lo = (N_LAUNCHES == 1) ? 0 : li; a.ph_hi = (N_LAUNCHES == 1) ? NPH : li + 1; a.li = li;
        hipLaunchKernelGGL(skel_fwd, dim3(grid), dim3(NWAVES * 64), LDS_BYTES, stream, a);
        const hipError_t le = hipPeekAtLastError();
        if (le != hipSuccess) { fprintf(stderr, "kernel_launch: launch %d failed: %s\n", li, hipGetErrorName(le)); break; }
    }
}
```
